# Optimizing an MI355X kernel written in HIP

```python
import jax, jax.numpy as jnp
from jax import lax
import numpy as np

D_MODEL = 2048
BATCH = 2
SEQ = 4096
DEPTH = 2
DEC_BATCH = 32
DEC_SEQ = 8
PAST_LEN = 16384
PAGE_SIZE = 128

N_MIXERS = 2
N_CONV_LAYERS = (DEPTH + N_MIXERS - 1) // N_MIXERS
N_ATTN_LAYERS = DEPTH // N_MIXERS
CONV_WIDTH = 3
HEAD_DIM = 64
N_HEADS = D_MODEL // HEAD_DIM
N_KV_HEADS = N_HEADS // 8
GROUP = N_HEADS // N_KV_HEADS
WINDOW = 128
BLOCK = WINDOW
D_FF = 4 * D_MODEL
ROPE_THETA = 10000.0
EPS = 1e-6

kernel_name = "hybrid_shortconv_swa_sink_step"


def rms_norm(x, g):
    xf = x.astype(jnp.float32)
    y = xf * lax.rsqrt(jnp.mean(xf * xf, axis=-1, keepdims=True) + EPS)
    return (y * g.astype(jnp.float32)).astype(x.dtype)


def rope(x, pos):
    half = HEAD_DIM // 2
    inv = ROPE_THETA ** (-jnp.arange(half, dtype=jnp.float32) / half)
    ang = pos.astype(jnp.float32)[:, None] * inv[None, :]
    cos = jnp.cos(ang)[None, :, None, :]
    sin = jnp.sin(ang)[None, :, None, :]
    xf = x.astype(jnp.float32)
    x1, x2 = xf[..., :half], xf[..., half:]
    return jnp.concatenate([x1 * cos - x2 * sin, x2 * cos + x1 * sin], axis=-1).astype(x.dtype)


def short_conv_mixer(h, conv_past, w_in, w_conv, w_out):
    T = h.shape[1]
    b_gate, c_gate, v = jnp.split(h @ w_in, 3, axis=-1)
    u = c_gate * v
    up = jnp.concatenate([conv_past.astype(u.dtype), u], axis=1)
    conv = w_conv[0] * up[:, 0:T]
    for kk in range(1, CONV_WIDTH):
        conv = conv + w_conv[kk] * up[:, kk:kk + T]
    y = (b_gate * conv) @ w_out
    return y, up[:, -(CONV_WIDTH - 1):]


def attn_project(h, pos, w_qkv, q_gain, k_gain):
    B, T, _ = h.shape
    qkv = h @ w_qkv
    q, k, v = jnp.split(qkv, [N_HEADS * HEAD_DIM, (N_HEADS + N_KV_HEADS) * HEAD_DIM], axis=-1)
    q = q.reshape(B, T, N_HEADS, HEAD_DIM)
    k = k.reshape(B, T, N_KV_HEADS, HEAD_DIM)
    v = v.reshape(B, T, N_KV_HEADS, HEAD_DIM)
    q = rope(rms_norm(q, q_gain), pos)
    k = rope(rms_norm(k, k_gain), pos)
    return q, k, v


def sink_softmax(s, sinks):
    sk = sinks.astype(jnp.float32).reshape(N_KV_HEADS, GROUP, 1, 1)
    m = jnp.maximum(jnp.max(s, axis=-1, keepdims=True), sk)
    p = jnp.exp(s - m)
    return p / (jnp.sum(p, axis=-1, keepdims=True) + jnp.exp(sk - m))


def swa_prompt(q, k, v, sinks):
    B, T = q.shape[:2]
    nb = T // BLOCK
    scale = HEAD_DIM ** -0.5
    qb = q.reshape(B, nb, BLOCK, N_KV_HEADS, GROUP, HEAD_DIM)
    kb = k.reshape(B, nb, BLOCK, N_KV_HEADS, HEAD_DIM)
    vb = v.reshape(B, nb, BLOCK, N_KV_HEADS, HEAD_DIM)
    kpad = jnp.zeros_like(kb[:, :1])
    vpad = jnp.zeros_like(vb[:, :1])
    k2 = jnp.concatenate([jnp.concatenate([kpad, kb[:, :-1]], axis=1), kb], axis=2)
    v2 = jnp.concatenate([jnp.concatenate([vpad, vb[:, :-1]], axis=1), vb], axis=2)
    s = jnp.einsum('bnqkgd,bnskd->bnkgqs', qb, k2, preferred_element_type=jnp.float32) * scale
    blk = jnp.arange(nb, dtype=jnp.int32)[:, None]
    qpos = blk * BLOCK + jnp.arange(BLOCK, dtype=jnp.int32)[None, :]
    kpos = (blk - 1) * BLOCK + jnp.arange(2 * BLOCK, dtype=jnp.int32)[None, :]
    diff = qpos[:, :, None] - kpos[:, None, :]
    mask = (diff >= 0) & (diff < WINDOW) & (kpos[:, None, :] >= 0)
    s = jnp.where(mask[None, :, None, None], s, -jnp.inf)
    p = sink_softmax(s, sinks)
    o = jnp.einsum('bnkgqs,bnskd->bnqkgd', p.astype(v.dtype), v2)
    return o.reshape(B, T, N_HEADS * HEAD_DIM)


def swa_sample(q, k_new, v_new, k_buf, v_buf, sinks, past_len):
    B, T = q.shape[:2]
    W = k_buf.shape[1]
    scale = HEAD_DIM ** -0.5
    k_all = jnp.concatenate([k_buf.astype(k_new.dtype), k_new], axis=1)
    v_all = jnp.concatenate([v_buf.astype(v_new.dtype), v_new], axis=1)
    qg = q.reshape(B, T, N_KV_HEADS, GROUP, HEAD_DIM)
    s = jnp.einsum('btkgd,bskd->bkgts', qg, k_all, preferred_element_type=jnp.float32) * scale
    qpos = past_len + jnp.arange(T, dtype=jnp.int32)
    kpos = past_len - W + jnp.arange(W + T, dtype=jnp.int32)
    diff = qpos[:, None] - kpos[None, :]
    mask = (diff >= 0) & (diff < WINDOW)
    s = jnp.where(mask[None, None, None], s, -jnp.inf)
    p = sink_softmax(s, sinks)
    o = jnp.einsum('bkgts,bskd->btkgd', p.astype(v_all.dtype), v_all)
    return o.reshape(B, T, N_HEADS * HEAD_DIM), k_all[:, -W:], v_all[:, -W:]


def sq_relu_mlp(h, w_up, w_down):
    a = jax.nn.relu(h @ w_up)
    return (a * a) @ w_down


def setup_inputs(seed: int = 0) -> dict:
    key = jax.random.key(seed)
    ks = jax.random.split(key, 20)
    f32 = jnp.float32
    D = D_MODEL
    W = min(WINDOW, PAST_LEN)
    qkv_cols = (N_HEADS + 2 * N_KV_HEADS) * HEAD_DIM
    nrm = lambda k, shape, s: jax.random.normal(k, shape, f32) * s
    return {
        "x_prompt": nrm(ks[0], (BATCH, SEQ, D), 1.0),
        "x_sample": nrm(ks[1], (DEC_BATCH, DEC_SEQ, D), 1.0),
        "state_conv": nrm(ks[2], (N_CONV_LAYERS, DEC_BATCH, CONV_WIDTH - 1, D), 1.0),
        "cache_k_win": nrm(ks[3], (N_ATTN_LAYERS, DEC_BATCH, W, N_KV_HEADS, HEAD_DIM), 1.0),
        "cache_v_win": nrm(ks[4], (N_ATTN_LAYERS, DEC_BATCH, W, N_KV_HEADS, HEAD_DIM), 1.0),
        "ln_mix": 1.0 + nrm(ks[5], (DEPTH, D), 0.02),
        "ln_mlp": 1.0 + nrm(ks[6], (DEPTH, D), 0.02),
        "w_conv_in": nrm(ks[7], (N_CONV_LAYERS, D, 3 * D), D ** -0.5),
        "w_conv": nrm(ks[8], (N_CONV_LAYERS, CONV_WIDTH, D), CONV_WIDTH ** -0.5),
        "w_conv_out": nrm(ks[9], (N_CONV_LAYERS, D, D), D ** -0.5),
        "w_qkv": nrm(ks[10], (N_ATTN_LAYERS, D, qkv_cols), D ** -0.5),
        "w_attn_out": nrm(ks[11], (N_ATTN_LAYERS, N_HEADS * HEAD_DIM, D), (N_HEADS * HEAD_DIM) ** -0.5),
        "q_norm": 1.0 + nrm(ks[12], (N_ATTN_LAYERS, HEAD_DIM), 0.02),
        "k_norm": 1.0 + nrm(ks[13], (N_ATTN_LAYERS, HEAD_DIM), 0.02),
        "sinks": nrm(ks[14], (N_ATTN_LAYERS, N_HEADS), 1.0),
        "w_up": nrm(ks[15], (DEPTH, D, D_FF), D ** -0.5),
        "w_down": nrm(ks[16], (DEPTH, D_FF, D), D_FF ** -0.5),
    }


def reference(x_prompt, x_sample, state_conv, cache_k_win, cache_v_win, ln_mix, ln_mlp,
              w_conv_in, w_conv, w_conv_out, w_qkv, w_attn_out, q_norm, k_norm, sinks,
              w_up, w_down):
    yp, ys = x_prompt, x_sample
    Bp, Tp, D = x_prompt.shape
    Ts = x_sample.shape[1]
    pos_p = jnp.arange(Tp, dtype=jnp.int32)
    pos_s = PAST_LEN + jnp.arange(Ts, dtype=jnp.int32)
    conv_p, conv_s, kp, vp, kss, vss = [], [], [], [], [], []
    for i in range(DEPTH):
        j = i // N_MIXERS
        hp = rms_norm(yp, ln_mix[i])
        hs = rms_norm(ys, ln_mix[i])
        if i % N_MIXERS == 0:
            zero_past = jnp.zeros((Bp, CONV_WIDTH - 1, D), hp.dtype)
            op, sp = short_conv_mixer(hp, zero_past, w_conv_in[j], w_conv[j], w_conv_out[j])
            os_, ss = short_conv_mixer(hs, state_conv[j], w_conv_in[j], w_conv[j], w_conv_out[j])
            conv_p.append(sp)
            conv_s.append(ss)
        else:
            q, k, v = attn_project(hp, pos_p, w_qkv[j], q_norm[j], k_norm[j])
            op = swa_prompt(q, k, v, sinks[j]) @ w_attn_out[j]
            kp.append(k[:, -WINDOW:])
            vp.append(v[:, -WINDOW:])
            q2, k2, v2 = attn_project(hs, pos_s, w_qkv[j], q_norm[j], k_norm[j])
            o2, kb, vb = swa_sample(q2, k2, v2, cache_k_win[j], cache_v_win[j], sinks[j], PAST_LEN)
            os_ = o2 @ w_attn_out[j]
            kss.append(kb)
            vss.append(vb)
        yp = yp + op
        ys = ys + os_
        yp = yp + sq_relu_mlp(rms_norm(yp, ln_mlp[i]), w_up[i], w_down[i])
        ys = ys + sq_relu_mlp(rms_norm(ys, ln_mlp[i]), w_up[i], w_down[i])
    return (yp, ys, jnp.stack(conv_p), jnp.stack(conv_s), jnp.stack(kp), jnp.stack(vp), jnp.stack(kss), jnp.stack(vss))
```

```cpp
#include <hip/hip_runtime.h>
#include <hip/hip_cooperative_groups.h>
#include <cstdio>
#include <cstdint>
namespace cg = cooperative_groups;
namespace pg8 {
#define PG8_LAS __attribute__((address_space(3)))
typedef unsigned short bf16_t;
typedef short bf16x8 __attribute__((ext_vector_type(8)));
typedef float f32x4 __attribute__((ext_vector_type(4)));
typedef unsigned u32x4 __attribute__((ext_vector_type(4)));
constexpr int BM = 256, BK = 64, HALF = 128, HTB = HALF * BK * 2  , STAGE_BYTES = 8 * HTB, NXCD = 8, WGM = 8;

__host__ __device__ __forceinline__ int lds_byte(int r, int c) { const int st = (r >> 4) * 2 + (c >> 5), rr = r & 15, cc = c & 31, ob = rr * 64 + cc * 2; return st * 1024 + (ob ^ (((ob >> 9) & 1) << 5)); }
__host__ __device__ __forceinline__ void stage_rc(int b, int& R, int& C) { const int st = b / 1024, sb = b % 1024, swz = sb ^ (((sb >> 9) & 1) << 5); R = (st >> 1) * 16 + swz / 64; C = (st & 1) * 32 + (swz % 64) / 2; }
__host__ __device__ __forceinline__ int perm32(int rho) { const int n = rho >> 4, i = rho & 15; return 8 * (i >> 2) + 4 * n + (i & 3); }

struct Unit { int pm, pn, nt, split; };
struct Gemm { const bf16_t* A; const bf16_t* Bt; int M, N, K; };

template <int M_, int N_, int K_> struct StaticOrderT {
    static constexpr int KDIM = K_, nM = M_ / BM, nN = N_ / BM, nwg = nM * nN, ntk = K_ / BK;
    int G, c;
    __device__ __forceinline__ bool next(int i, Unit& u) const { const long L = (long)i * G + c; if (L >= nwg) return false; map((int)L, u); return true; }
    static __device__ __forceinline__ void map(int L, Unit& u) {
        u.nt = ntk; u.split = 0;
        int wgid = L; { constexpr int q = nwg / NXCD, r = nwg % NXCD; const int xcd = wgid % NXCD, off = wgid / NXCD; wgid = (xcd < r ? xcd * (q + 1) : r * (q + 1) + (xcd - r) * q) + off; }
        constexpr int nig = WGM * nN; const int gid = wgid / nig, fm = gid * WGM, gsz = (nM - fm) < WGM ? (nM - fm) : WGM;
        u.pm = fm + ((wgid % nig) % gsz); u.pn = (wgid % nig) / gsz;
    }
    __device__ __forceinline__ void a_ready(const Unit&) const {}
    __device__ __forceinline__ void done(const Unit&) const {}
};
template <int K_, int NS> struct SplitOrderT {
    typedef StaticOrderT<8192, 2048, K_> Base;
    static constexpr int KDIM = K_, ntS = K_ / BK / NS;
    int G, c;
    __device__ __forceinline__ bool next(int i, Unit& u) const {
        const int L = i * G + c; const bool isb = L < Base::nwg; const int j = L - Base::nwg;
        Unit b; Base::map(isb ? L : 0, b);
        u.pm = isb ? b.pm : Base::nM; u.pn = isb ? b.pn : (j % Base::nN); u.split = isb ? 0 : (j / Base::nN); u.nt = isb ? Base::ntk : ntS;
        return isb || j < Base::nN * NS;
    }
    __device__ __forceinline__ void a_ready(const Unit&) const {}
    __device__ __forceinline__ void done(const Unit&) const {}
};

__device__ __forceinline__ unsigned cvt_pk_bf16(float lo, float hi) { unsigned r; asm volatile("v_cvt_pk_bf16_f32 %0, %1, %2" : "=v"(r) : "v"(lo), "v"(hi)); return r; }
template <int ACT  , int ID = 0  > struct EpiBf16 {
    static constexpr bool PERM = true, AFTER_DRAIN = false;
    bf16_t* O; int ldc;
    __device__ __forceinline__ void operator()(const f32x4 (&acc)[2][2][4][2], const Unit& u, int wr, int wc, int fr, int fq) const {
        asm volatile("" : "+v"(fr), "+v"(fq));
        const int row0 = u.pm * BM + wr * 64 + fr; const int col0 = u.pn * BM + wc * 32 + 8 * fq;
#pragma unroll
        for (int ai = 0; ai < 2; ++ai)
#pragma unroll
            for (int m = 0; m < 4; ++m) { bf16_t* rowp = O + (size_t)(row0 + ai * HALF + m * 16) * ldc + col0;
#pragma unroll
                for (int bj = 0; bj < 2; ++bj) { f32x4 v0 = acc[ai][bj][m][0], v1 = acc[ai][bj][m][1];
                    if (ACT == 1) {
#pragma unroll
                        for (int e = 0; e < 4; ++e) { const float a = fmaxf(v0[e], 0.f), b = fmaxf(v1[e], 0.f); v0[e] = a * a; v1[e] = b * b; } }
                    u32x4 w; w.x = cvt_pk_bf16(v0[0], v0[1]); w.y = cvt_pk_bf16(v0[2], v0[3]); w.z = cvt_pk_bf16(v1[0], v1[1]); w.w = cvt_pk_bf16(v1[2], v1[3]);
                    *(u32x4*)(rowp + bj * HALF) = w; } }
    }
};
template <int ID = 0> struct EpiRes {
    static constexpr bool PERM = false, AFTER_DRAIN = false;
    const float* srcP; float* dst; float* part;
    __device__ __forceinline__ void operator()(const f32x4 (&acc)[2][2][4][2], const Unit& u, int wr, int wc, int fr, int fq) const {
        asm volatile("" : "+v"(fr), "+v"(fq));
        const bool sp = u.pm >= 32;
        float* wb = (sp ? part + (size_t)u.split * (BM * 2048) : dst + (size_t)u.pm * (BM * 2048)) + (u.pn * BM + wc * 32 + 4 * fq);
        const float* sb = (srcP != nullptr && !sp) ? srcP + (size_t)u.pm * (BM * 2048) + (u.pn * BM + wc * 32 + 4 * fq) : wb;
#pragma unroll
        for (int ai = 0; ai < 2; ++ai)
#pragma unroll
            for (int m = 0; m < 4; ++m) { const int off = (ai * HALF + wr * 64 + m * 16 + fr) * 2048;
                f32x4 v[2][2];
#pragma unroll
                for (int bj = 0; bj < 2; ++bj)
#pragma unroll
                    for (int n = 0; n < 2; ++n) v[bj][n] = (f32x4){0.f, 0.f, 0.f, 0.f};
                if (!sp) {
#pragma unroll
                    for (int bj = 0; bj < 2; ++bj)
#pragma unroll
                        for (int n = 0; n < 2; ++n) v[bj][n] = *(const f32x4*)(sb + off + bj * HALF + n * 16);
                }
#pragma unroll
                for (int bj = 0; bj < 2; ++bj)
#pragma unroll
                    for (int n = 0; n < 2; ++n) *(f32x4*)(wb + off + bj * HALF + n * 16) = v[bj][n] + acc[ai][bj][m][n];
                asm volatile("" ::: "memory"); }
    }
};

template <class Epi, class Sched, bool ALIGN_EPI = false, bool SP2 = false>
__device__ __forceinline__ void gemm_phase(PG8_LAS unsigned char* lds, const Gemm g, const Sched& S, const Epi& E) {
    int tid_ = threadIdx.x; asm volatile("" : "+v"(tid_)); const int tid = tid_, wid = __builtin_amdgcn_readfirstlane(tid >> 6), lane = tid & 63, wr = wid >> 2, wc = wid & 3, fr = lane & 15, fq = lane >> 4;
    constexpr int K = Sched::KDIM;
    unsigned voffA[2], voffB[2];
#pragma unroll
    for (int i = 0; i < 2; ++i) { int R, C; stage_rc(tid * 16 + i * 8192, R, C); const int Rb = Epi::PERM ? ((R & ~31) + perm32(R & 31)) : R;
        voffA[i] = (unsigned)(R * K + C) * 2u; voffB[i] = (unsigned)(Rb * K + C) * 2u; }
    const size_t kstep = (size_t)(BK * 2);
    const size_t hstep = (size_t)HALF * K * 2;
    const size_t tstep = 2 * hstep;
    const unsigned ldsw = (unsigned)wid * 1024u;
    const int aoff = lds_byte(wr * 64 + fr, fq * 8), boff = lds_byte(wc * 32 + fr, fq * 8);
#define PG8_SA(b, h) (((b) * 2 + (h)) * HTB)
#define PG8_SB(b, h) ((4 + (b) * 2 + (h)) * HTB)
#define PG8_STAGE(bufoff, gbase, voff) do { _Pragma("unroll") for (int _i = 0; _i < 2; ++_i) \
        __builtin_amdgcn_global_load_lds((const unsigned*)((const char*)(gbase) + (voff)[_i]), (PG8_LAS unsigned*)(lds + (bufoff) + ldsw + _i * 8192), 16, 0, 0); } while (0)
#define PG8_LDA(dst, b, h) do { _Pragma("unroll") for (int m = 0; m < 4; ++m) _Pragma("unroll") for (int k = 0; k < 2; ++k) dst[m][k] = *(const PG8_LAS bf16x8*)(lds + PG8_SA(b, h) + aoff + m * 2048 + k * 1024); } while (0)
#define PG8_LDB(dst, b, h) do { _Pragma("unroll") for (int n = 0; n < 2; ++n) _Pragma("unroll") for (int k = 0; k < 2; ++k) dst[n][k] = *(const PG8_LAS bf16x8*)(lds + PG8_SB(b, h) + boff + n * 2048 + k * 1024); } while (0)
#define PG8_MMA(ai, bj, At, Bt) do { __builtin_amdgcn_s_setprio(1); _Pragma("unroll") for (int m = 0; m < 4; ++m) _Pragma("unroll") for (int n = 0; n < 2; ++n) _Pragma("unroll") for (int k = 0; k < 2; ++k) \
        acc[ai][bj][m][n] = __builtin_amdgcn_mfma_f32_16x16x32_bf16(Bt[n][k], At[m][k], acc[ai][bj][m][n], 0, 0, 0); __builtin_amdgcn_s_setprio(0); } while (0)
#define PG8_WAIT_V(n) asm volatile("s_waitcnt vmcnt(" #n ")" ::: "memory")
#define PG8_WAIT_L(n) asm volatile("s_waitcnt lgkmcnt(" #n ")" ::: "memory")
#define PG8_BAR __builtin_amdgcn_s_barrier()
#define PG8_SCHED __builtin_amdgcn_sched_barrier(0)
    Unit cur, nxt; int ui = 0;
    if (!S.next(0, cur)) return;
    f32x4 acc[2][2][4][2];
#pragma unroll
    for (int a = 0; a < 2; ++a)
#pragma unroll
        for (int b = 0; b < 2; ++b)
#pragma unroll
            for (int m = 0; m < 4; ++m)
#pragma unroll
                for (int n = 0; n < 2; ++n) acc[a][b][m][n] = (f32x4){0.f, 0.f, 0.f, 0.f};
    bf16x8 At[4][2], B0[2][2], B1[2][2];
    const char* cA = (const char*)g.A + (size_t)cur.pm * tstep + (size_t)(cur.split * cur.nt) * kstep; const char* cB = (const char*)g.Bt + (size_t)cur.pn * tstep + (size_t)(cur.split * cur.nt) * kstep;
    S.a_ready(cur);
    if constexpr (SP2) {
        PG8_STAGE(PG8_SB(0, 0), cB, voffB); PG8_STAGE(PG8_SB(0, 1), cB + hstep, voffB); PG8_STAGE(PG8_SA(0, 0), cA, voffA); PG8_STAGE(PG8_SA(0, 1), cA + hstep, voffA);
        if (wr == 1) PG8_BAR;
        PG8_WAIT_V(2); PG8_BAR;
        PG8_STAGE(PG8_SB(1, 0), cB + kstep, voffB); PG8_STAGE(PG8_SA(1, 0), cA + kstep, voffA); PG8_STAGE(PG8_SB(1, 1), cB + hstep + kstep, voffB);
        PG8_WAIT_V(6); PG8_BAR;
    } else {
        PG8_STAGE(PG8_SB(0, 0), cB, voffB); PG8_STAGE(PG8_SA(0, 0), cA, voffA); PG8_STAGE(PG8_SB(0, 1), cB + hstep, voffB); PG8_STAGE(PG8_SA(0, 1), cA + hstep, voffA);
        if (wr == 1) PG8_BAR;
        PG8_WAIT_V(4); PG8_BAR;
        PG8_STAGE(PG8_SB(1, 0), cB + kstep, voffB); PG8_STAGE(PG8_SA(1, 0), cA + kstep, voffA); PG8_STAGE(PG8_SB(1, 1), cB + hstep + kstep, voffB);
        PG8_WAIT_V(6); PG8_BAR;
    }
    for (;;) {
        const bool has_next = S.next(ui + 1, nxt);
        const char* nA = has_next ? (const char*)g.A + (size_t)nxt.pm * tstep + (size_t)(nxt.split * nxt.nt) * kstep : cA; const char* nB = has_next ? (const char*)g.Bt + (size_t)nxt.pn * tstep + (size_t)(nxt.split * nxt.nt) * kstep : cB;
        const int nt = cur.nt;
        for (int t = 0; t < nt; t += 2) {
            const bool last = (t == nt - 2);
            const char* a1 = cA + (size_t)(t + 1) * kstep;
            const char* a2 = last ? nA : cA + (size_t)(t + 2) * kstep; const char* b2 = last ? nB : cB + (size_t)(t + 2) * kstep;
            const char* a3 = a2 + kstep; const char* b3 = b2 + kstep;
            if (last && has_next) S.a_ready(nxt);
            if constexpr (SP2) {
            PG8_LDB(B0, 0, 0); PG8_LDB(B1, 0, 1); PG8_SCHED; PG8_LDA(At, 0, 0); PG8_STAGE(PG8_SA(1, 1), a1 + hstep, voffA);
            PG8_WAIT_V(8); PG8_WAIT_L(0); PG8_BAR; PG8_MMA(0, 0, At, B0); PG8_MMA(0, 1, At, B1); PG8_BAR; PG8_SCHED;
            PG8_LDA(At, 0, 1); PG8_STAGE(PG8_SB(0, 0), b2, voffB); PG8_STAGE(PG8_SB(0, 1), b2 + hstep, voffB); PG8_STAGE(PG8_SA(0, 0), a2, voffA);
            PG8_WAIT_V(8); PG8_WAIT_L(0); PG8_BAR; PG8_MMA(1, 0, At, B0); PG8_MMA(1, 1, At, B1); PG8_BAR; PG8_SCHED;
            PG8_LDB(B0, 1, 0); PG8_LDB(B1, 1, 1); PG8_SCHED; PG8_LDA(At, 1, 0); PG8_STAGE(PG8_SA(0, 1), a2 + hstep, voffA);
            PG8_WAIT_V(8); PG8_WAIT_L(0); PG8_BAR; PG8_MMA(0, 0, At, B0); PG8_MMA(0, 1, At, B1); PG8_BAR; PG8_SCHED;
            PG8_LDA(At, 1, 1); PG8_STAGE(PG8_SB(1, 0), b3, voffB); PG8_STAGE(PG8_SB(1, 1), b3 + hstep, voffB); PG8_STAGE(PG8_SA(1, 0), a3, voffA);
            PG8_WAIT_V(8); PG8_WAIT_L(0); PG8_BAR; PG8_MMA(1, 0, At, B0); PG8_MMA(1, 1, At, B1); PG8_BAR; PG8_SCHED;
            } else {
            PG8_LDB(B0, 0, 0); PG8_SCHED; PG8_LDA(At, 0, 0); PG8_STAGE(PG8_SA(1, 1), a1 + hstep, voffA);
            PG8_WAIT_L(8); PG8_BAR; PG8_WAIT_L(0); PG8_MMA(0, 0, At, B0); PG8_BAR; PG8_SCHED;
            PG8_LDB(B1, 0, 1); PG8_STAGE(PG8_SB(0, 0), b2, voffB);
            PG8_BAR; PG8_WAIT_L(0); PG8_MMA(0, 1, At, B1); PG8_BAR;
            PG8_LDA(At, 0, 1); PG8_STAGE(PG8_SA(0, 0), a2, voffA);
            PG8_BAR; PG8_WAIT_L(0); PG8_MMA(1, 0, At, B0); PG8_BAR; PG8_SCHED;
            PG8_STAGE(PG8_SB(0, 1), b2 + hstep, voffB);
            PG8_WAIT_V(6); PG8_BAR; PG8_MMA(1, 1, At, B1); PG8_BAR;
            PG8_LDB(B0, 1, 0); PG8_SCHED; PG8_LDA(At, 1, 0); PG8_STAGE(PG8_SA(0, 1), a2 + hstep, voffA);
            PG8_WAIT_L(8); PG8_BAR; PG8_WAIT_L(0); PG8_MMA(0, 0, At, B0); PG8_BAR; PG8_SCHED;
            PG8_LDB(B1, 1, 1); PG8_STAGE(PG8_SB(1, 0), b3, voffB);
            PG8_BAR; PG8_WAIT_L(0); PG8_MMA(0, 1, At, B1); PG8_BAR;
            PG8_LDA(At, 1, 1); PG8_STAGE(PG8_SA(1, 0), a3, voffA);
            PG8_BAR; PG8_WAIT_L(0); PG8_MMA(1, 0, At, B0); PG8_BAR; PG8_SCHED;
            PG8_STAGE(PG8_SB(1, 1), b3 + hstep, voffB);
            PG8_WAIT_V(6); PG8_BAR; PG8_MMA(1, 1, At, B1); PG8_BAR;
            }
        }
        if constexpr (ALIGN_EPI) { if (wr == 0) PG8_BAR; }
        if constexpr (!Epi::AFTER_DRAIN) { E(acc, cur, wr, wc, fr, fq); S.done(cur); }
        if (!has_next) break;
#pragma unroll
        for (int a = 0; a < 2; ++a)
#pragma unroll
            for (int b = 0; b < 2; ++b)
#pragma unroll
                for (int m = 0; m < 4; ++m)
#pragma unroll
                    for (int n = 0; n < 2; ++n) acc[a][b][m][n] = (f32x4){0.f, 0.f, 0.f, 0.f};
        cur = nxt; cA = nA; cB = nB; ++ui;
        if constexpr (ALIGN_EPI) { if (wr == 1) PG8_BAR; }
    }
    PG8_WAIT_V(0);
    if constexpr (!ALIGN_EPI) { if (wr == 0) PG8_BAR; }
    PG8_BAR;
    if constexpr (Epi::AFTER_DRAIN) { E.fused(acc, cur, wr, wc, fr, fq, lds, wid, lane); S.done(cur); }
#undef PG8_SA
#undef PG8_SB
#undef PG8_STAGE
#undef PG8_LDA
#undef PG8_LDB
#undef PG8_MMA
#undef PG8_WAIT_V
#undef PG8_WAIT_L
#undef PG8_BAR
#undef PG8_SCHED
}
}
constexpr int D = 2048, SEQ = 4096, NBATCH = 2, MP = NBATCH * SEQ, DEC_B = 32, DEC_T = 8, MS = DEC_B * DEC_T, M = MP + MS;
constexpr int FF = 8192, NIN = 3 * D, HD = 64, NH = 32, NKV = 4, KVW = NKV * HD, NQKV = NH * HD + 2 * KVW, PAST = 16384, WIN = 128;
constexpr int SKF = WIN + DEC_T;
constexpr int SVP = 144;
constexpr float EPS = 1e-6f, LOG2E = 1.4426950408889634f, QSCALE = 0.125f * LOG2E;
constexpr size_t O_CP = (size_t)M * D, O_CS = O_CP + (size_t)NBATCH * 2 * D, O_KP = O_CS + (size_t)DEC_B * 2 * D, O_VP = O_KP + (size_t)NBATCH * WIN * KVW,
                 O_KS = O_VP + (size_t)NBATCH * WIN * KVW, O_VS = O_KS + (size_t)DEC_B * WIN * KVW;
constexpr size_t MiB = 1u << 20;
constexpr size_t WS_WIN = 0, WS_WOUT = 24 * MiB, WS_WQKV = 32 * MiB, WS_WATT = 42 * MiB, WS_WUP0 = 50 * MiB, WS_WUP1 = 82 * MiB, WS_WDN0 = 114 * MiB, WS_WDN1 = 146 * MiB;
constexpr size_t WS_H = 180 * MiB, WS_R = 214 * MiB, WS_A = WS_R, WS_BCV = WS_R, WS_G = WS_R + 99 * MiB, WS_QKV = WS_R + 132 * MiB  , WS_Q = WS_R + 42 * MiB, WS_O = WS_R + 75 * MiB;
constexpr size_t WS_KP = WS_R + 108 * MiB, WS_VTP = WS_R + 112 * MiB, WS_KS = WS_R + 116 * MiB, WS_VTS = WS_R + 119 * MiB, WS_HX = WS_R + 174 * MiB  , WS_END = WS_HX + 99 * MiB;
static_assert((size_t)8448 * 6144 * 2 <= 99 * MiB && (size_t)8448 * 8192 * 2 <= 132 * MiB && (size_t)8448 * 2560 * 2 <= 42 * MiB && (size_t)8448 * 2048 * 2 <= 33 * MiB, "ws map");
constexpr size_t WS_PART = WS_QKV;
constexpr size_t WS_BAR = 178 * MiB;
constexpr int LDS_RING = 131072, LDS_BYTES = LDS_RING + 64;
constexpr int NTHREADS = 512, NWAVES = 8;

#define LAS __attribute__((address_space(3)))
typedef unsigned short bf16;
typedef float f32x4 __attribute__((ext_vector_type(4)));
typedef unsigned u32x4 __attribute__((ext_vector_type(4)));
typedef unsigned u32x2 __attribute__((ext_vector_type(2)));
typedef short bf16x8 __attribute__((ext_vector_type(8)));
__device__ __forceinline__ float bf2f(unsigned v) { return __uint_as_float(v << 16); }
__device__ __forceinline__ float bflo(unsigned w) { return __uint_as_float(w << 16); }
__device__ __forceinline__ float bfhi(unsigned w) { return __uint_as_float(w & 0xffff0000u); }
__device__ __forceinline__ unsigned pk2(float lo, float hi) { return pg8::cvt_pk_bf16(lo, hi); }
__device__ __forceinline__ float shx(float v, int o, int lane) { return __int_as_float(__builtin_amdgcn_ds_bpermute((lane ^ o) << 2, __float_as_int(v))); }
__device__ __forceinline__ float wave_sum(float v, int lane) {
#pragma unroll
    for (int o = 1; o < 64; o <<= 1) v += shx(v, o, lane);
    return v;
}
__device__ const double ROPE_INV[32] = {1.0, 0.7498942093324559, 0.5623413251903491, 0.4216965034285822, 0.31622776601683794, 0.23713737056616552, 0.1778279410038923, 0.1333521432163324,
    0.1, 0.07498942093324558, 0.05623413251903491, 0.042169650342858224, 0.03162277660168379, 0.023713737056616554, 0.01778279410038923, 0.01333521432163324,
    0.01, 0.007498942093324558, 0.005623413251903491, 0.004216965034285823, 0.0031622776601683794, 0.0023713737056616554, 0.0017782794100389228, 0.001333521432163324,
    0.001, 0.0007498942093324559, 0.0005623413251903491, 0.00042169650342858224, 0.00031622776601683794, 0.00023713737056616554, 0.00017782794100389227, 0.0001333521432163324};

__device__ __forceinline__ void transpose_item(const float* __restrict__ W, const float* __restrict__ gain, bf16* __restrict__ WT, int K, int N, int item, LAS unsigned* T, int lane) {
    const int nblk = N >> 6, kb = item / nblk, nb = item - kb * nblk, k0 = kb * 64, n0 = nb * 64;
    const int j = lane & 15, g = lane >> 4;
    const float* src = W + (size_t)(k0 + 2 * g) * N + n0 + 4 * j;
    f32x4 a[8], b[8];
#pragma unroll
    for (int i = 0; i < 8; ++i) { a[i] = *(const f32x4*)(src + (size_t)(8 * i) * N); b[i] = *(const f32x4*)(src + (size_t)(8 * i + 1) * N); }
    if (gain != nullptr) {
#pragma unroll
        for (int i = 0; i < 8; ++i) { const float ga = gain[k0 + 8 * i + 2 * g], gb = gain[k0 + 8 * i + 2 * g + 1]; a[i] = a[i] * ga; b[i] = b[i] * gb; }
    }
#pragma unroll
    for (int i = 0; i < 8; ++i) {
        const int r = 4 * i + g;
#pragma unroll
        for (int e = 0; e < 4; ++e) T[(4 * j + e) * 33 + r] = pk2(a[i][e], b[i][e]);
    }
    asm volatile("s_waitcnt lgkmcnt(0)" ::: "memory");
    const int c = lane & 7;
#pragma unroll
    for (int q = 0; q < 8; ++q) {
        const int n = (lane >> 3) + 8 * q; const LAS unsigned* s = T + n * 33 + 4 * c;
        u32x4 o; o.x = s[0]; o.y = s[1]; o.z = s[2]; o.w = s[3];
        *(u32x4*)(WT + (size_t)(n0 + n) * K + k0 + 8 * c) = o;
    }
    asm volatile("s_waitcnt lgkmcnt(0)" ::: "memory");
}

__device__ __forceinline__ void rms_rows(const float* srcP, const float* srcS, bf16* __restrict__ H, float* copyS, const float* part, int nsplit, int gw, int ngw, int lane) {
    for (int row = gw; row < M; row += ngw) {
        const float* xr = (row < MP) ? srcP + (size_t)row * D : srcS + (size_t)(row - MP) * D;
        f32x4 v[8]; float ss = 0.f;
#pragma unroll
        for (int j = 0; j < 4; ++j) { v[2 * j] = *(const f32x4*)(xr + j * 512 + lane * 8); v[2 * j + 1] = *(const f32x4*)(xr + j * 512 + lane * 8 + 4); }
        if (part != nullptr && row >= MP) {
            const float* pr = part + (size_t)(row - MP) * D;
            for (int s = 0; s < nsplit; ++s, pr += (size_t)MS * D) {
#pragma unroll
                for (int j = 0; j < 4; ++j) { v[2 * j] += *(const f32x4*)(pr + j * 512 + lane * 8); v[2 * j + 1] += *(const f32x4*)(pr + j * 512 + lane * 8 + 4); }
            }
        }
#pragma unroll
        for (int j = 0; j < 8; ++j) ss += (v[j][0] * v[j][0] + v[j][1] * v[j][1]) + (v[j][2] * v[j][2] + v[j][3] * v[j][3]);
        ss = wave_sum(ss, lane);
        const float rstd = 1.0f / sqrtf(ss * (1.0f / D) + EPS);
        bf16* hr = H + (size_t)row * D;
#pragma unroll
        for (int j = 0; j < 4; ++j) { const f32x4 p = v[2 * j] * rstd, q = v[2 * j + 1] * rstd; u32x4 o; o.x = pk2(p[0], p[1]); o.y = pk2(p[2], p[3]); o.z = pk2(q[0], q[1]); o.w = pk2(q[2], q[3]);
            *(u32x4*)(hr + j * 512 + lane * 8) = o; }
        if (copyS != nullptr && row >= MP) { float* cr = copyS + (size_t)(row - MP) * D;
#pragma unroll
            for (int j = 0; j < 4; ++j) { *(f32x4*)(cr + j * 512 + lane * 8) = v[2 * j]; *(f32x4*)(cr + j * 512 + lane * 8 + 4) = v[2 * j + 1]; } }
    }
}

__device__ __forceinline__ void reduce_sample(float* __restrict__ yS, const float* __restrict__ part, int nsplit, int gw, int ngw, int lane) {
    for (int row = gw; row < MS; row += ngw) {
        float* yr = yS + (size_t)row * D; f32x4 v[8];
#pragma unroll
        for (int j = 0; j < 4; ++j) { v[2 * j] = *(const f32x4*)(yr + j * 512 + lane * 8); v[2 * j + 1] = *(const f32x4*)(yr + j * 512 + lane * 8 + 4); }
        const float* pr = part + (size_t)row * D;
        for (int s = 0; s < nsplit; ++s, pr += (size_t)MS * D) {
#pragma unroll
            for (int j = 0; j < 4; ++j) { v[2 * j] += *(const f32x4*)(pr + j * 512 + lane * 8); v[2 * j + 1] += *(const f32x4*)(pr + j * 512 + lane * 8 + 4); }
        }
#pragma unroll
        for (int j = 0; j < 4; ++j) { *(f32x4*)(yr + j * 512 + lane * 8) = v[2 * j]; *(f32x4*)(yr + j * 512 + lane * 8 + 4) = v[2 * j + 1]; }
    }
}

__device__ __forceinline__ void unpack8(const u32x4 w, float (&f)[8]) { f[0] = bflo(w.x); f[1] = bfhi(w.x); f[2] = bflo(w.y); f[3] = bfhi(w.y); f[4] = bflo(w.z); f[5] = bfhi(w.z); f[6] = bflo(w.w); f[7] = bfhi(w.w); }
__device__ __forceinline__ void conv_phase(const bf16* __restrict__ bcv, const float* __restrict__ state, const float* __restrict__ wconv, bf16* __restrict__ G, float* __restrict__ out_cp, float* __restrict__ out_cs, int gtid, int nthreads) {
    for (int item = gtid; item < (M / 8) * 256; item += nthreads) {
        const int rb = item >> 8, dc = item & 255, d0 = dc * 8, r0 = rb * 8;
        float w0[8], w1[8], w2[8], up2[8], up1[8];
        { const f32x4 a = *(const f32x4*)(wconv + d0), b = *(const f32x4*)(wconv + d0 + 4), c = *(const f32x4*)(wconv + D + d0), d = *(const f32x4*)(wconv + D + d0 + 4), e = *(const f32x4*)(wconv + 2 * D + d0), f = *(const f32x4*)(wconv + 2 * D + d0 + 4);
#pragma unroll
          for (int k = 0; k < 4; ++k) { w0[k] = a[k]; w0[4 + k] = b[k]; w1[k] = c[k]; w1[4 + k] = d[k]; w2[k] = e[k]; w2[4 + k] = f[k]; } }
        const bool samp = r0 >= MP; const int sb = (r0 - MP) >> 3;
        if (samp) {
            const f32x4 a = *(const f32x4*)(state + (size_t)(sb * 2) * D + d0), b = *(const f32x4*)(state + (size_t)(sb * 2) * D + d0 + 4), c = *(const f32x4*)(state + (size_t)(sb * 2 + 1) * D + d0), d = *(const f32x4*)(state + (size_t)(sb * 2 + 1) * D + d0 + 4);
#pragma unroll
            for (int k = 0; k < 4; ++k) { up2[k] = a[k]; up2[4 + k] = b[k]; up1[k] = c[k]; up1[4 + k] = d[k]; }
        } else if ((r0 & (SEQ - 1)) == 0) {
#pragma unroll
            for (int k = 0; k < 8; ++k) { up2[k] = 0.f; up1[k] = 0.f; }
        } else {
            float c[8], v[8];
            unpack8(*(const u32x4*)(bcv + (size_t)(r0 - 2) * NIN + D + d0), c); unpack8(*(const u32x4*)(bcv + (size_t)(r0 - 2) * NIN + 2 * D + d0), v);
#pragma unroll
            for (int k = 0; k < 8; ++k) up2[k] = c[k] * v[k];
            unpack8(*(const u32x4*)(bcv + (size_t)(r0 - 1) * NIN + D + d0), c); unpack8(*(const u32x4*)(bcv + (size_t)(r0 - 1) * NIN + 2 * D + d0), v);
#pragma unroll
            for (int k = 0; k < 8; ++k) up1[k] = c[k] * v[k];
        }
#pragma unroll
        for (int rr = 0; rr < 8; ++rr) {
            const bf16* rp = bcv + (size_t)(r0 + rr) * NIN + d0;
            float bg[8], c[8], v[8], u[8], g[8];
            unpack8(*(const u32x4*)rp, bg); unpack8(*(const u32x4*)(rp + D), c); unpack8(*(const u32x4*)(rp + 2 * D), v);
#pragma unroll
            for (int k = 0; k < 8; ++k) { u[k] = c[k] * v[k]; g[k] = bg[k] * (w0[k] * up2[k] + w1[k] * up1[k] + w2[k] * u[k]); up2[k] = up1[k]; up1[k] = u[k]; }
            u32x4 o; o.x = pk2(g[0], g[1]); o.y = pk2(g[2], g[3]); o.z = pk2(g[4], g[5]); o.w = pk2(g[6], g[7]);
            *(u32x4*)(G + (size_t)(r0 + rr) * D + d0) = o;
        }
        float* op = nullptr;
        if (samp) op = out_cs + (size_t)(sb * 2) * D + d0;
        else if ((r0 & (SEQ - 1)) == SEQ - 8) op = out_cp + (size_t)((r0 >> 12) * 2) * D + d0;
        if (op != nullptr) {
            *(f32x4*)op = (f32x4){up2[0], up2[1], up2[2], up2[3]}; *(f32x4*)(op + 4) = (f32x4){up2[4], up2[5], up2[6], up2[7]};
            *(f32x4*)(op + D) = (f32x4){up1[0], up1[1], up1[2], up1[3]}; *(f32x4*)(op + D + 4) = (f32x4){up1[4], up1[5], up1[6], up1[7]};
        }
    }
}

struct PostArgs { const bf16* raw; const float* qn; const float* kn; const float* cache_k; const float* cache_v; bf16* Q; bf16* KP; bf16* VTP; bf16* KS; bf16* VTS; float* out; };
__device__ __forceinline__ void post_phase(const PostArgs& P, int gw, int ngw, int lane, int gtid, int nthreads, int parts  ) {
    if (parts & 1) {
        const int i = lane & 31, hsel = lane >> 5; const double inv = ROPE_INV[i];
        const float gq1 = P.qn[i], gq2 = P.qn[32 + i], gk1 = P.kn[i], gk2 = P.kn[32 + i];
        for (int row = gw; row < M; row += ngw) {
            const bool samp = row >= MP; int b, t, pos;
            if (!samp) { b = row >> 12; t = row & (SEQ - 1); pos = t; } else { b = (row - MP) >> 3; t = (row - MP) & 7; pos = PAST + t; }
            const double rev = (double)pos * inv * 0.15915494309189535; const float fr = (float)(rev - __builtin_rint(rev));
            const float sn = __builtin_amdgcn_sinf(fr), cs = __builtin_amdgcn_cosf(fr);
            const bf16* src = P.raw + (size_t)row * NQKV;
#pragma unroll 2
            for (int jj = 0; jj < 18; ++jj) {
                const int hh = 2 * jj + hsel;
                const float x1 = bf2f(src[hh * 64 + i]), x2 = bf2f(src[hh * 64 + 32 + i]);
                float ss = x1 * x1 + x2 * x2;
#pragma unroll
                for (int o = 1; o < 32; o <<= 1) ss += shx(ss, o, lane);
                const float rstd = 1.0f / sqrtf(ss * (1.0f / HD) + EPS);
                const bool isq = hh < NH;
                const float y1 = x1 * rstd * (isq ? gq1 : gk1), y2 = x2 * rstd * (isq ? gq2 : gk2);
                const float o1 = y1 * cs - y2 * sn, o2 = y2 * cs + y1 * sn;
                if (isq) { bf16* q = P.Q + (size_t)row * D + hh * 64 + i; q[0] = (bf16)pk2(o1 * QSCALE, 0.f); q[32] = (bf16)pk2(o2 * QSCALE, 0.f); }
                else {
                    const int kvh = hh - NH;
                    if (!samp) { bf16* k = P.KP + (size_t)row * KVW + kvh * 64 + i; k[0] = (bf16)pk2(o1, 0.f); k[32] = (bf16)pk2(o2, 0.f);
                        if (t >= SEQ - WIN) { float* o = P.out + O_KP + ((size_t)(b * WIN + (t - (SEQ - WIN))) * NKV + kvh) * HD + i; o[0] = o1; o[32] = o2; } }
                    else { bf16* k = P.KS + ((size_t)b * SKF + WIN + t) * KVW + kvh * 64 + i; k[0] = (bf16)pk2(o1, 0.f); k[32] = (bf16)pk2(o2, 0.f);
                        float* o = P.out + O_KS + ((size_t)(b * WIN + (WIN - DEC_T) + t) * NKV + kvh) * HD + i; o[0] = o1; o[32] = o2; }
                }
            }
        }
    }
    for (int item = (parts & 1) ? gw : M; item < M / 8; item += ngw) {
        const int r0 = item * 8; const int c4 = 4 * lane, kvh = c4 >> 6, d = c4 & 63;
        float v[8][4];
#pragma unroll
        for (int rr = 0; rr < 8; ++rr) { const u32x2 w = *(const u32x2*)(P.raw + (size_t)(r0 + rr) * NQKV + NH * HD + KVW + c4); v[rr][0] = bflo(w.x); v[rr][1] = bfhi(w.x); v[rr][2] = bflo(w.y); v[rr][3] = bfhi(w.y); }
        if (r0 < MP) {
            const int b = r0 >> 12, t0 = r0 & (SEQ - 1);
#pragma unroll
            for (int e = 0; e < 4; ++e) { u32x4 o; o.x = pk2(v[0][e], v[1][e]); o.y = pk2(v[2][e], v[3][e]); o.z = pk2(v[4][e], v[5][e]); o.w = pk2(v[6][e], v[7][e]);
                *(u32x4*)(P.VTP + ((size_t)(b * NKV + kvh) * HD + d + e) * SEQ + t0) = o; }
            if (t0 >= SEQ - WIN) {
#pragma unroll
                for (int rr = 0; rr < 8; ++rr) *(f32x4*)(P.out + O_VP + (size_t)(b * WIN + (t0 + rr - (SEQ - WIN))) * KVW + c4) = (f32x4){v[rr][0], v[rr][1], v[rr][2], v[rr][3]};
            }
        } else {
            const int b = (r0 - MP) >> 3;
#pragma unroll
            for (int e = 0; e < 4; ++e) { u32x4 o; o.x = pk2(v[0][e], v[1][e]); o.y = pk2(v[2][e], v[3][e]); o.z = pk2(v[4][e], v[5][e]); o.w = pk2(v[6][e], v[7][e]);
                bf16* vp = P.VTS + ((size_t)(b * NKV + kvh) * HD + d + e) * SVP; *(u32x4*)(vp + WIN) = o; *(u32x4*)(vp + WIN + 8) = (u32x4){0u, 0u, 0u, 0u}; }
#pragma unroll
            for (int rr = 0; rr < 8; ++rr) *(f32x4*)(P.out + O_VS + (size_t)(b * WIN + (WIN - DEC_T) + rr) * KVW + c4) = (f32x4){v[rr][0], v[rr][1], v[rr][2], v[rr][3]};
        }
    }
    for (int idx = (parts & 2) ? gtid : DEC_B * WIN * (KVW / 4); idx < DEC_B * WIN * (KVW / 4); idx += nthreads) {
        const int f = idx & (WIN - 1), c4 = ((idx >> 7) & 63) * 4, b = idx >> 13, kvh = c4 >> 6, d = c4 & 63;
        const f32x4 kc = *(const f32x4*)(P.cache_k + ((size_t)b * WIN + f) * KVW + c4), vc = *(const f32x4*)(P.cache_v + ((size_t)b * WIN + f) * KVW + c4);
        u32x2 kk; kk.x = pk2(kc[0], kc[1]); kk.y = pk2(kc[2], kc[3]);
        *(u32x2*)(P.KS + ((size_t)b * SKF + f) * KVW + c4) = kk;
#pragma unroll
        for (int e = 0; e < 4; ++e) P.VTS[((size_t)(b * NKV + kvh) * HD + d + e) * SVP + f] = (bf16)pk2(vc[e], 0.f);
        if (f >= DEC_T) { *(f32x4*)(P.out + O_KS + ((size_t)b * WIN + f - DEC_T) * KVW + c4) = kc; *(f32x4*)(P.out + O_VS + ((size_t)b * WIN + f - DEC_T) * KVW + c4) = vc; }
    }
}

constexpr int KROW = 144, VROW = 528, ATT_K_BYTES = 256 * KROW;
__device__ __forceinline__ void attn_phase(LAS unsigned char* lds, const bf16* __restrict__ Q, const bf16* __restrict__ KP, const bf16* __restrict__ VTP, const bf16* __restrict__ KS, const bf16* __restrict__ VTS,
                                           const float* __restrict__ sinks, bf16* __restrict__ O, int G) {
    int tid_ = threadIdx.x; asm volatile("" : "+v"(tid_)); const int tid = tid_, lane = tid & 63, wid = __builtin_amdgcn_readfirstlane(tid >> 6), fr = lane & 15, fq = lane >> 4;
    LAS unsigned char* Ksm = lds; LAS unsigned char* Vsm = lds + ATT_K_BYTES;
    for (int u = blockIdx.x; u < 256; u += G) {
        int nq, qrow0, f0, nk, nkv, kvh, vpitch; const bf16* kbase; const bf16* vbase;
        if (u < 256) { const int b = u >> 7, n = u & 31; kvh = (u >> 5) & 3; nq = 128; qrow0 = b * SEQ + n * 128; f0 = (n == 0) ? 128 : 0; nk = 256; nkv = 256;
            kbase = KP + ((long)(b * SEQ) + (long)(n - 1) * 128) * KVW + kvh * 64; vbase = VTP + (long)((b * NKV + kvh) * HD) * SEQ + (long)(n - 1) * 128; vpitch = SEQ; }
        else { const int s = u - 256, b = s >> 2; kvh = s & 3; nq = DEC_T; qrow0 = MP + b * DEC_T; f0 = 0; nk = SKF; nkv = SVP;
            kbase = KS + (long)b * SKF * KVW + kvh * 64; vbase = VTS + (long)((b * NKV + kvh) * HD) * SVP; vpitch = SVP; }
#pragma unroll
        for (int i = 0; i < 4; ++i) { const int id = tid + NTHREADS * i, f = id >> 3, c = id & 7; u32x4 v = (u32x4){0u, 0u, 0u, 0u};
            if (f >= f0 && f < nk) v = *(const u32x4*)(kbase + (long)f * KVW + c * 8);
            *(LAS u32x4*)(Ksm + f * KROW + c * 16) = v; }
#pragma unroll
        for (int i = 0; i < 4; ++i) { const int id = tid + NTHREADS * i, d = id >> 5, c = id & 31; u32x4 v = (u32x4){0u, 0u, 0u, 0u};
            if (8 * c >= f0 && 8 * c < nkv) v = *(const u32x4*)(vbase + (long)d * vpitch + 8 * c);
            *(LAS u32x4*)(Vsm + d * VROW + c * 16) = v; }
        __syncthreads();
        const int h = kvh * 8 + wid; const float sink2 = sinks[h] * LOG2E;
        const int nsub = (nq + 15) >> 4;
        for (int sp = 0; sp < 4; ++sp) {
            const int iA = 32 * sp + fr, iB = iA + 16, ktb = 2 * sp;
            const bf16* qpA = Q + (size_t)(qrow0 + iA) * D + h * 64 + 8 * fq; const bf16* qpB = qpA + 16 * D;
            const bf16x8 qA0 = *(const bf16x8*)qpA, qA1 = *(const bf16x8*)(qpA + 32), qB0 = *(const bf16x8*)qpB, qB1 = *(const bf16x8*)(qpB + 32);
            f32x4 sA[10], sB[10];
#pragma unroll
            for (int j = 0; j < 10; ++j) { const LAS unsigned char* kr = Ksm + (16 * (ktb + j) + fr) * KROW + fq * 16;
                const bf16x8 a0 = *(const LAS bf16x8*)kr, a1 = *(const LAS bf16x8*)(kr + 64);
                f32x4 accA = (f32x4){0.f, 0.f, 0.f, 0.f}, accB = accA;
                accA = __builtin_amdgcn_mfma_f32_16x16x32_bf16(a0, qA0, accA, 0, 0, 0); accB = __builtin_amdgcn_mfma_f32_16x16x32_bf16(a0, qB0, accB, 0, 0, 0);
                accA = __builtin_amdgcn_mfma_f32_16x16x32_bf16(a1, qA1, accA, 0, 0, 0); accB = __builtin_amdgcn_mfma_f32_16x16x32_bf16(a1, qB1, accB, 0, 0, 0); sA[j] = accA; sB[j] = accB; }
            float mxA = -INFINITY, mxB = -INFINITY;
#pragma unroll
            for (int j = 0; j < 10; ++j)
#pragma unroll
                for (int e = 0; e < 4; ++e) { const int f = 16 * (ktb + j) + 4 * fq + e;
                    const bool okA = (f >= iA + 1) && (f <= iA + WIN) && (f >= f0), okB = (f >= iB + 1) && (f <= iB + WIN) && (f >= f0);
                    sA[j][e] = okA ? sA[j][e] : -INFINITY; mxA = fmaxf(mxA, sA[j][e]); sB[j][e] = okB ? sB[j][e] : -INFINITY; mxB = fmaxf(mxB, sB[j][e]); }
            mxA = fmaxf(mxA, shx(mxA, 16, lane)); mxB = fmaxf(mxB, shx(mxB, 16, lane)); mxA = fmaxf(mxA, shx(mxA, 32, lane)); mxB = fmaxf(mxB, shx(mxB, 32, lane));
            mxA = fmaxf(mxA, sink2); mxB = fmaxf(mxB, sink2);
            float lA = 0.f, lB = 0.f;
#pragma unroll
            for (int j = 0; j < 10; ++j)
#pragma unroll
                for (int e = 0; e < 4; ++e) { const float pA = __builtin_amdgcn_exp2f(sA[j][e] - mxA), pB = __builtin_amdgcn_exp2f(sB[j][e] - mxB); sA[j][e] = pA; lA += pA; sB[j][e] = pB; lB += pB; }
            lA += shx(lA, 16, lane); lB += shx(lB, 16, lane); lA += shx(lA, 32, lane); lB += shx(lB, 32, lane);
            lA += __builtin_amdgcn_exp2f(sink2 - mxA); lB += __builtin_amdgcn_exp2f(sink2 - mxB);
            f32x4 oA[4], oB[4];
#pragma unroll
            for (int dt = 0; dt < 4; ++dt) { oA[dt] = (f32x4){0.f, 0.f, 0.f, 0.f}; oB[dt] = oA[dt]; }
#pragma unroll
            for (int jp = 0; jp < 5; ++jp) {
                u32x4 pw; pw.x = pk2(sA[2 * jp][0], sA[2 * jp][1]); pw.y = pk2(sA[2 * jp][2], sA[2 * jp][3]); pw.z = pk2(sA[2 * jp + 1][0], sA[2 * jp + 1][1]); pw.w = pk2(sA[2 * jp + 1][2], sA[2 * jp + 1][3]);
                const bf16x8 pbA = __builtin_bit_cast(bf16x8, pw);
                pw.x = pk2(sB[2 * jp][0], sB[2 * jp][1]); pw.y = pk2(sB[2 * jp][2], sB[2 * jp][3]); pw.z = pk2(sB[2 * jp + 1][0], sB[2 * jp + 1][1]); pw.w = pk2(sB[2 * jp + 1][2], sB[2 * jp + 1][3]);
                const bf16x8 pbB = __builtin_bit_cast(bf16x8, pw);
#pragma unroll
                for (int dt = 0; dt < 4; ++dt) { const LAS unsigned char* vr = Vsm + (16 * dt + fr) * VROW + (16 * (ktb + 2 * jp) + 4 * fq) * 2;
                    const u32x2 lo = *(const LAS u32x2*)vr, hi = *(const LAS u32x2*)(vr + 32);
                    const bf16x8 a = __builtin_bit_cast(bf16x8, (u32x4){lo.x, lo.y, hi.x, hi.y});
                    oA[dt] = __builtin_amdgcn_mfma_f32_16x16x32_bf16(a, pbA, oA[dt], 0, 0, 0); oB[dt] = __builtin_amdgcn_mfma_f32_16x16x32_bf16(a, pbB, oB[dt], 0, 0, 0); }
            }
            const float rlA = 1.0f / lA, rlB = 1.0f / lB;
            bf16* opA = O + (size_t)(qrow0 + iA) * D + h * 64 + 4 * fq; bf16* opB = opA + 16 * D;
#pragma unroll
            for (int dt = 0; dt < 4; ++dt) { u32x2 w; w.x = pk2(oA[dt][0] * rlA, oA[dt][1] * rlA); w.y = pk2(oA[dt][2] * rlA, oA[dt][3] * rlA); *(u32x2*)(opA + 16 * dt) = w;
                w.x = pk2(oB[dt][0] * rlB, oB[dt][1] * rlB); w.y = pk2(oB[dt][2] * rlB, oB[dt][3] * rlB); *(u32x2*)(opB + 16 * dt) = w; }
        }
        __syncthreads();
    }
}

__device__ __forceinline__ void sample_attn(const bf16* __restrict__ Q, const bf16* __restrict__ KS, const bf16* __restrict__ VTS, const float* __restrict__ sinks, bf16* __restrict__ O, int gw, int ngw, int lane) {
    for (int item = gw; item < MS * NH; item += ngw) {
        const int r = item >> 5, h = item & 31, b = r >> 3, t = r & 7, kvh = h >> 3;
        const bf16* qp = Q + (size_t)(MP + r) * D + h * 64;
        float q[64];
#pragma unroll
        for (int c = 0; c < 8; ++c) { const u32x4 w = *(const u32x4*)(qp + 8 * c); q[8 * c] = bflo(w.x); q[8 * c + 1] = bfhi(w.x); q[8 * c + 2] = bflo(w.y); q[8 * c + 3] = bfhi(w.y); q[8 * c + 4] = bflo(w.z); q[8 * c + 5] = bfhi(w.z); q[8 * c + 6] = bflo(w.w); q[8 * c + 7] = bfhi(w.w); }
        const bf16* vp = VTS + ((size_t)(b * NKV + kvh) * HD + lane) * SVP;
        u32x4 vv[17];
#pragma unroll
        for (int c = 0; c < 17; ++c) vv[c] = *(const u32x4*)(vp + 8 * c);
        float sc[3]; float mx = sinks[h] * LOG2E; const float sink2 = mx;
#pragma unroll
        for (int k = 0; k < 3; ++k) {
            const int f = lane + 64 * k; float s = -INFINITY;
            if (f >= t + 1 && f <= t + WIN && f < SKF) {
                const bf16* kp = KS + ((size_t)b * SKF + f) * KVW + kvh * 64; s = 0.f;
#pragma unroll
                for (int c = 0; c < 8; ++c) { const u32x4 w = *(const u32x4*)(kp + 8 * c);
                    s += q[8 * c] * bflo(w.x) + q[8 * c + 1] * bfhi(w.x) + q[8 * c + 2] * bflo(w.y) + q[8 * c + 3] * bfhi(w.y) + q[8 * c + 4] * bflo(w.z) + q[8 * c + 5] * bfhi(w.z) + q[8 * c + 6] * bflo(w.w) + q[8 * c + 7] * bfhi(w.w); }
            }
            sc[k] = s; mx = fmaxf(mx, s);
        }
#pragma unroll
        for (int o = 1; o < 64; o <<= 1) mx = fmaxf(mx, shx(mx, o, lane));
        float l = 0.f;
#pragma unroll
        for (int k = 0; k < 3; ++k) { sc[k] = __builtin_amdgcn_exp2f(sc[k] - mx); l += sc[k]; }
        l = wave_sum(l, lane) + __builtin_amdgcn_exp2f(sink2 - mx);
        float o = 0.f;
#pragma unroll
        for (int c = 0; c < 17; ++c) {
            const int k = (8 * c) >> 6;
#pragma unroll
            for (int e = 0; e < 8; ++e) { const int f = 8 * c + e; const float pf = __int_as_float(__builtin_amdgcn_ds_bpermute((f & 63) << 2, __float_as_int(sc[k])));
                const unsigned w = (e < 2) ? vv[c].x : (e < 4) ? vv[c].y : (e < 6) ? vv[c].z : vv[c].w; o += pf * ((e & 1) ? bfhi(w) : bflo(w)); }
        }
        O[(size_t)(MP + r) * D + h * 64 + lane] = (bf16)pk2(o / l, 0.f);
    }
}

#define XB_TMO      128
#define XB_XCNT(j)  (256  + 64 * (j))
#define XB_XSUB(j)  (1280 + 64 * (j))
#define XB_XGEN(j)  (2304 + 64 * (j))
#define XB_TOP      3328
#define XB_TOPGEN   3392
#define XCD_BAR_WORDS 3456
#define XB_SPIN_CAP (1u << 18)

__device__ __forceinline__ unsigned xb_ld(unsigned* p)              { return __hip_atomic_load(p, __ATOMIC_RELAXED, __HIP_MEMORY_SCOPE_AGENT); }
__device__ __forceinline__ unsigned xb_add(unsigned* p, unsigned v) { return __hip_atomic_fetch_add(p, v, __ATOMIC_RELAXED, __HIP_MEMORY_SCOPE_AGENT); }
__device__ __forceinline__ unsigned xb_xcc_id() { return (unsigned)__builtin_amdgcn_s_getreg((3 << 11) | 20) & 0xFu; }
#define XB_SPIN(cond, bar) do { unsigned _sp = 0; while (cond) { __builtin_amdgcn_s_sleep(1); \
    if ((++_sp & 255u) == 0u) { if (xb_ld(&(bar)[XB_TMO])) break; if (_sp > XB_SPIN_CAP) { atomicAdd(&(bar)[XB_TMO], 1u); break; } } } } while (0)

struct XcdBarrier {
    unsigned* bar; unsigned x;
    volatile LAS unsigned* st;
};

__device__ __forceinline__ XcdBarrier xcd_barrier_post(unsigned* bar, volatile LAS unsigned* st) {
    XcdBarrier b; b.bar = bar; b.x = xb_xcc_id(); b.st = st;
    if (threadIdx.x == 0) (void)xb_add(&bar[XB_XCNT(b.x)], 1u);
    return b;
}
__device__ __forceinline__ void xcd_barrier_complete(unsigned* bar, unsigned x, unsigned& nloc, unsigned& nx) {
    const unsigned G = gridDim.x * gridDim.y * gridDim.z;
    unsigned sum, cnt, mine, sp = 0u;
    for (;;) {
        sum = 0u; cnt = 0u; mine = 0u;
#pragma unroll
        for (unsigned j = 0; j < 16; ++j) { const unsigned c = xb_ld(&bar[XB_XCNT(j)]); sum += c; cnt += (c > 0u) ? 1u : 0u; mine = (j == x) ? c : mine; }
        if (sum == G) break;
        __builtin_amdgcn_s_sleep(1);
        if ((++sp & 255u) == 0u) { if (xb_ld(&bar[XB_TMO])) break; if (sp > XB_SPIN_CAP) { atomicAdd(&bar[XB_TMO], 1u); break; } }
    }
    nloc = mine > 0u ? mine : 1u; nx = cnt > 0u ? cnt : 1u;
}

__device__ __forceinline__ void xcd_barrier(const XcdBarrier& b) {
    asm volatile("s_waitcnt vmcnt(0)" ::: "memory");
    __syncthreads();
    if (threadIdx.x == 0) {
        unsigned* bar = b.bar;
        __builtin_amdgcn_s_waitcnt(0);
        unsigned nloc = b.st[0], nx = b.st[1];
        if (nloc == 0u) { xcd_barrier_complete(bar, b.x, nloc, nx); b.st[0] = nloc; b.st[1] = nx; }
        const unsigned old = xb_add(&bar[XB_XSUB(b.x)], 1u);
        const unsigned gen = old / nloc;
        if (old + 1u == (gen + 1u) * nloc) {
            __builtin_amdgcn_fence(__ATOMIC_RELEASE, "agent");
            asm volatile("s_waitcnt vmcnt(0)" ::: "memory");
            const unsigned og = xb_add(&bar[XB_TOP], 1u);
            const unsigned tg = og / nx;
            if (og + 1u == (tg + 1u) * nx) xb_add(&bar[XB_TOPGEN], 1u);
            else XB_SPIN(xb_ld(&bar[XB_TOPGEN]) == tg, bar);
            __builtin_amdgcn_fence(__ATOMIC_ACQUIRE, "agent");
            xb_add(&bar[XB_XGEN(b.x)], 1u);
            asm volatile("s_waitcnt vmcnt(0)" ::: "memory");
        } else {
            XB_SPIN(xb_ld(&bar[XB_XGEN(b.x)]) == gen, bar);
            __builtin_amdgcn_fence(__ATOMIC_ACQUIRE, "agent");
            asm volatile("s_waitcnt vmcnt(0)" ::: "memory");
        }
    }
    __syncthreads();
}

struct Args { const float* in[17]; float* out; unsigned char* ws; int ph_lo, ph_hi; };
template <int BYTE_OFF> __device__ __forceinline__ const float* karg_ptr() {
    __attribute__((address_space(1))) const float* p; const char* ka = (const char*)__builtin_amdgcn_kernarg_segment_ptr();
    asm volatile("s_load_dwordx2 %0, %1, %2\n\ts_waitcnt lgkmcnt(0)" : "=s"(p) : "s"(ka), "n"(BYTE_OFF) : "memory");
    return (const float*)p;
}
#define ARG_IN(i) karg_ptr<8 * (i)>()

struct GemmDesc { const bf16* A; const bf16* Bt; int N, K, type, ldc; bf16* outb; const float* srcP; };

__global__ void __launch_bounds__(NTHREADS, 2) fwd_megakernel(Args a) {
    extern __shared__ __attribute__((aligned(16))) unsigned char lds_raw[];
    cg::grid_group grid = cg::this_grid();
    LAS unsigned char* lds = (LAS unsigned char*)lds_raw;
    const int G = gridDim.x, ngw = G * NWAVES, nthreads = G * NTHREADS;
    if (threadIdx.x < 16) ((LAS unsigned*)(lds + LDS_RING))[threadIdx.x] = 0u;
    __syncthreads();
    (void)xcd_barrier_post((unsigned*)((unsigned char*)karg_ptr<144>() + WS_BAR), (volatile LAS unsigned*)(lds + LDS_RING));
#ifndef DBG_PH
#define DBG_PH 15
#endif
#pragma unroll 1
    for (int ph = a.ph_lo; ph <= a.ph_hi; ++ph) {
        int tid_ = threadIdx.x; asm volatile("" : "+v"(tid_));
        const int tid = tid_, lane = tid & 63, wave = __builtin_amdgcn_readfirstlane(tid >> 6);
        const int gw = blockIdx.x * NWAVES + wave, gtid = blockIdx.x * NTHREADS + tid;
        unsigned char* ws = (unsigned char*)karg_ptr<144>(); float* out = (float*)karg_ptr<136>();
    bf16* const WT[8] = {(bf16*)(ws + WS_WIN), (bf16*)(ws + WS_WOUT), (bf16*)(ws + WS_WQKV), (bf16*)(ws + WS_WATT), (bf16*)(ws + WS_WUP0), (bf16*)(ws + WS_WUP1), (bf16*)(ws + WS_WDN0), (bf16*)(ws + WS_WDN1)};
    bf16* const H0 = (bf16*)(ws + WS_H); bf16* const H1 = (bf16*)(ws + WS_HX); bf16* const H2 = (bf16*)(ws + WS_HX + 33 * MiB); bf16* const H3 = (bf16*)(ws + WS_HX + 66 * MiB); bf16* const BCV = (bf16*)(ws + WS_BCV); bf16* const GB = (bf16*)(ws + WS_G); bf16* const AB = (bf16*)(ws + WS_A);
    bf16* const QKV = (bf16*)(ws + WS_QKV); bf16* const QB = (bf16*)(ws + WS_Q); bf16* const OB = (bf16*)(ws + WS_O);
    bf16* const KP = (bf16*)(ws + WS_KP); bf16* const VTP = (bf16*)(ws + WS_VTP); bf16* const KS = (bf16*)(ws + WS_KS); bf16* const VTS = (bf16*)(ws + WS_VTS);

        const bool tails = G >= 128;
#define CONVERT_ITEMS(LO, HI, FIRST, STRIDE) { LAS unsigned* T = (LAS unsigned*)(lds + wave * (64 * 33 * 4)); \
            for (int it = (LO) + (FIRST); it < (HI); it += (STRIDE)) { \
                int r = it; const float* W; const float* gain = nullptr; bf16* dst; int K = D, N; \
                if (r < 3072) { W = ARG_IN(7); gain = ARG_IN(5); dst = WT[0]; N = NIN; } \
                else if ((r -= 3072) < 1024) { W = ARG_IN(9); dst = WT[1]; N = D; } \
                else if ((r -= 1024) < 1280) { W = ARG_IN(10); gain = ARG_IN(5) + D; dst = WT[2]; N = NQKV; } \
                else if ((r -= 1280) < 1024) { W = ARG_IN(11); dst = WT[3]; N = D; } \
                else if ((r -= 1024) < 4096) { W = ARG_IN(15); gain = ARG_IN(6); dst = WT[4]; N = FF; } \
                else if ((r -= 4096) < 4096) { W = ARG_IN(15) + (size_t)D * FF; gain = ARG_IN(6) + D; dst = WT[5]; N = FF; } \
                else if ((r -= 4096) < 4096) { W = ARG_IN(16); dst = WT[6]; K = FF; N = D; } \
                else { r -= 4096; W = ARG_IN(16) + (size_t)D * FF; dst = WT[7]; K = FF; N = D; } \
                transpose_item(W, gain, dst, K, N, r, T, lane); } }
#ifdef DBG_EMPTY_FROM
        if (ph >= DBG_EMPTY_FROM) {   } else
#endif
        if (ph == 0) {
            if (tails) { CONVERT_ITEMS(0, 3072, gw, ngw) } else { CONVERT_ITEMS(0, 22784, gw, ngw) }
            rms_rows(ARG_IN(0), ARG_IN(1), H0, out + (size_t)MP * D, nullptr, 0, gw, ngw, lane);
        } else if (ph == 2) {
            conv_phase(BCV, ARG_IN(2), ARG_IN(8), GB, out + O_CP, out + O_CS, gtid, nthreads);
        } else if (ph == 4 || ph == 7 || ph == 12) {
            rms_rows(out, out + (size_t)MP * D, ph == 4 ? H1 : (ph == 7 ? H2 : H3), out + (size_t)MP * D, (const float*)(ws + WS_PART), ph == 7 ? 16 : 8, gw, ngw, lane);
        } else if (ph == 15) {
            reduce_sample(out + (size_t)MP * D, (const float*)(ws + WS_PART), 16, gw, ngw, lane);
        } else if (ph == 9) {
            PostArgs P{QKV, ARG_IN(12), ARG_IN(13), ARG_IN(3), ARG_IN(4), QB, KP, VTP, KS, VTS, out};
            post_phase(P, gw, ngw, lane, gtid, nthreads, tails ? 1 : 3);
        } else if (ph == 10) {
            attn_phase(lds, QB, KP, VTP, KS, VTS, ARG_IN(14), OB, G);
            sample_attn(QB, KS, VTS, ARG_IN(14), OB, gw, ngw, lane);
        } else {
#define RUN_BF16(ACT, ID, Aptr, Bptr, NN, KK, OUT) { const pg8::Gemm gg{Aptr, Bptr, M, NN, KK}; pg8::StaticOrderT<M, NN, KK> S; S.G = G; S.c = (int)blockIdx.x; const pg8::EpiBf16<ACT, ID> E{OUT, NN}; \
                pg8::gemm_phase<pg8::EpiBf16<ACT, ID>, pg8::StaticOrderT<M, NN, KK>, true, true>(lds, gg, S, E); }
#define RUN_RES(ID, Aptr, Bptr, KK, NS, SRCP) { const pg8::Gemm gg{Aptr, Bptr, M, D, KK}; pg8::SplitOrderT<KK, NS> S; S.G = G; S.c = (int)blockIdx.x; const pg8::EpiRes<ID> E{SRCP, out, (float*)(ws + WS_PART)}; \
                pg8::gemm_phase<pg8::EpiRes<ID>, pg8::SplitOrderT<KK, NS>, true, true>(lds, gg, S, E); }
            if (ph == 1) RUN_BF16(0, 1, H0, WT[0], NIN, D, BCV)
            else if (ph == 3) RUN_RES(3, GB, WT[1], D, 8, ARG_IN(0))
            else if (ph == 5) RUN_BF16(1, 5, H1, WT[4], FF, D, AB)
            else if (ph == 6) RUN_RES(6, AB, WT[6], FF, 16, nullptr)
            else if (ph == 8) RUN_BF16(0, 8, H2, WT[2], NQKV, D, QKV)
            else if (ph == 11) RUN_RES(11, OB, WT[3], D, 8, nullptr)
            else if (ph == 13) RUN_BF16(1, 13, H3, WT[5], FF, D, AB)
            else RUN_RES(14, AB, WT[7], FF, 16, nullptr)
#undef RUN_BF16
#undef RUN_RES
            if (tails && ph == 1 && blockIdx.x >= 24) { const int hw = ((int)blockIdx.x - 24) * NWAVES + wave, nhw = (G - 24) * NWAVES;
                CONVERT_ITEMS(3072, 4096, hw, nhw) CONVERT_ITEMS(6400, 10496, hw, nhw) CONVERT_ITEMS(14592, 18688, hw, nhw) }
            if (tails && ph == 8 && blockIdx.x >= 74) {
                PostArgs P{QKV, ARG_IN(12), ARG_IN(13), ARG_IN(3), ARG_IN(4), QB, KP, VTP, KS, VTS, out};
                post_phase(P, 0, 1, lane, ((int)blockIdx.x - 74) * NTHREADS + tid, (G - 74) * NTHREADS, 2); }
            if (tails && ph == 5 && blockIdx.x >= 32) { const int hw = ((int)blockIdx.x - 32) * NWAVES + wave, nhw = (G - 32) * NWAVES;
                CONVERT_ITEMS(4096, 6400, hw, nhw) CONVERT_ITEMS(10496, 14592, hw, nhw) CONVERT_ITEMS(18688, 22784, hw, nhw) }
        }
        if (a.ph_lo == 0 && (ph != a.ph_hi || DBG_PH != 15)) {
            XcdBarrier xb; xb.bar = (unsigned*)(ws + WS_BAR); xb.x = xb_xcc_id(); xb.st = (volatile LAS unsigned*)(lds + LDS_RING);
            xcd_barrier(xb);
        } else
        if (ph != a.ph_hi || DBG_PH != 15) {
            asm volatile("s_waitcnt vmcnt(0)" ::: "memory");
            __syncthreads();
            if (threadIdx.x == 0) { __builtin_amdgcn_fence(__ATOMIC_RELEASE, "agent"); asm volatile("s_waitcnt vmcnt(0)" ::: "memory"); }
            grid.sync();
            if (threadIdx.x == 0) { __builtin_amdgcn_fence(__ATOMIC_ACQUIRE, "agent"); asm volatile("s_waitcnt vmcnt(0)" ::: "memory"); }
            __syncthreads();
        }
    }
#if DBG_PH != 15
    {
        const int gtid = blockIdx.x * NTHREADS + threadIdx.x; unsigned char* ws = (unsigned char*)karg_ptr<144>(); float* out = (float*)karg_ptr<136>();
        const unsigned* w0 = (const unsigned*)(ws); const unsigned* w1 = (const unsigned*)(ws + WS_H); const unsigned* w2 = (const unsigned*)(ws + WS_R);
        unsigned x0 = 0, x1 = 0, x2 = 0;
        for (size_t i = gtid; i < (178 * MiB) / 4; i += nthreads) x0 ^= w0[i];
        for (size_t i = gtid; i < (33 * MiB) / 4; i += nthreads) x1 ^= w1[i];
        for (size_t i = gtid; i < (174 * MiB) / 4; i += nthreads) x2 ^= w2[i];
        out[O_KS + gtid] = (float)((x0 ^ (x0 >> 12)) & 0xfffffu); out[O_KS + nthreads + gtid] = (float)((x1 ^ (x1 >> 12)) & 0xfffffu); out[O_KS + 2 * nthreads + gtid] = (float)((x2 ^ (x2 >> 12)) & 0xfffffu);
    }
#endif
}

extern "C" void kernel_launch(void* const* d_in, const int* in_sizes, int n_in, void* d_out, int out_size, void* d_ws, size_t ws_size, hipStream_t stream) {
    static int grid_blocks = 0;
    if (grid_blocks == 0) {
        if (n_in != 17 || ws_size < WS_END) { fprintf(stderr, "kernel_launch: unexpected inputs (n_in %d, ws %zu)\n", n_in, ws_size); grid_blocks = -1; return; }
        int dev = 0, cus = 0, per_cu = 0;
        if (hipGetDevice(&dev) != hipSuccess || hipDeviceGetAttribute(&cus, hipDeviceAttributeMultiprocessorCount, dev) != hipSuccess) { grid_blocks = -1; return; }
        if (hipFuncSetAttribute((const void*)fwd_megakernel, hipFuncAttributeMaxDynamicSharedMemorySize, LDS_BYTES) != hipSuccess) { fprintf(stderr, "kernel_launch: hipFuncSetAttribute failed\n"); grid_blocks = -1; return; }
        if (hipOccupancyMaxActiveBlocksPerMultiprocessor(&per_cu, (const void*)fwd_megakernel, NTHREADS, LDS_BYTES) != hipSuccess || per_cu < 1) { fprintf(stderr, "kernel_launch: occupancy query reports %d blocks per CU\n", per_cu); grid_blocks = -1; return; }
        grid_blocks = cus;
    }
    if (grid_blocks < 0) return;
    Args a{};
    for (int i = 0; i < 17; ++i) a.in[i] = (const float*)d_in[i];
    a.out = (float*)d_out; a.ws = (unsigned char*)d_ws;
#ifndef MK_LAUNCHES
#define MK_LAUNCHES 1
#endif
    if (hipMemsetAsync((char*)d_ws + WS_BAR, 0, 16384, stream) != hipSuccess) { fprintf(stderr, "kernel_launch: hipMemsetAsync of the barrier words failed\n"); return; }
    void* args[] = {&a};
    if (MK_LAUNCHES == 1) {
        a.ph_lo = 0; a.ph_hi = DBG_PH;
        hipError_t e = hipLaunchCooperativeKernel((const void*)fwd_megakernel, dim3(grid_blocks), dim3(NTHREADS), args, LDS_BYTES, stream);
        if (e != hipSuccess) fprintf(stderr, "cooperative launch failed: %s (grid %d)\n", hipGetErrorString(e), grid_blocks);
    } else {
        for (int ph = 0; ph <= DBG_PH; ++ph) {
            a.ph_lo = ph; a.ph_hi = ph;
            hipError_t e = hipLaunchCooperativeKernel((const void*)fwd_megakernel, dim3(grid_blocks), dim3(NTHREADS), args, LDS_BYTES, stream);
            if (e != hipSuccess) { fprintf(stderr, "launch %d failed: %s\n", ph, hipGetErrorString(e)); break; }
        }
    }
}
```

```cpp
#include <hip/hip_runtime.h>
#include <hip/hip_cooperative_groups.h>
#include <cstdio>
#include <cstdint>
namespace cg = cooperative_groups;
namespace pg8 {
#define PG8_LAS __attribute__((address_space(3)))
typedef unsigned short bf16_t;
typedef short bf16x8 __attribute__((ext_vector_type(8)));
typedef float f32x4 __attribute__((ext_vector_type(4)));
typedef unsigned u32x4 __attribute__((ext_vector_type(4)));
constexpr int BM = 256, BK = 64, HALF = 128, HTB = HALF * BK * 2  , STAGE_BYTES = 8 * HTB, NXCD = 8, WGM = 8;

__host__ __device__ __forceinline__ int lds_byte(int r, int c) { const int st = (r >> 4) * 2 + (c >> 5), rr = r & 15, cc = c & 31, ob = rr * 64 + cc * 2; return st * 1024 + (ob ^ (((ob >> 9) & 1) << 5)); }
__host__ __device__ __forceinline__ void stage_rc(int b, int& R, int& C) { const int st = b / 1024, sb = b % 1024, swz = sb ^ (((sb >> 9) & 1) << 5); R = (st >> 1) * 16 + swz / 64; C = (st & 1) * 32 + (swz % 64) / 2; }
__host__ __device__ __forceinline__ int perm32(int rho) { const int n = rho >> 4, i = rho & 15; return 8 * (i >> 2) + 4 * n + (i & 3); }

struct Unit { int pm, pn, nt, split; };
struct Gemm { const bf16_t* A; const bf16_t* Bt; int M, N, K; };

template <int M_, int N_, int K_> struct StaticOrderT {
    static constexpr int KDIM = K_, nM = M_ / BM, nN = N_ / BM, nwg = nM * nN, ntk = K_ / BK;
    int G, c;
    __device__ __forceinline__ bool next(int i, Unit& u) const { const long L = (long)i * G + c; if (L >= nwg) return false; map((int)L, u); return true; }
    static __device__ __forceinline__ void map(int L, Unit& u) {
        u.nt = ntk; u.split = 0;
        int wgid = L; { constexpr int q = nwg / NXCD, r = nwg % NXCD; const int xcd = wgid % NXCD, off = wgid / NXCD; wgid = (xcd < r ? xcd * (q + 1) : r * (q + 1) + (xcd - r) * q) + off; }
        constexpr int nig = WGM * nN; const int gid = wgid / nig, fm = gid * WGM, gsz = (nM - fm) < WGM ? (nM - fm) : WGM;
        u.pm = fm + ((wgid % nig) % gsz); u.pn = (wgid % nig) / gsz;
    }
    __device__ __forceinline__ void a_ready(const Unit&) const {}
    __device__ __forceinline__ void done(const Unit&) const {}
};
template <int K_, int NS> struct SplitOrderT {
    typedef StaticOrderT<8192, 2048, K_> Base;
    static constexpr int KDIM = K_, ntS = K_ / BK / NS;
    int G, c;
    __device__ __forceinline__ bool next(int i, Unit& u) const {
        const int L = i * G + c; const bool isb = L < Base::nwg; const int j = L - Base::nwg;
        Unit b; Base::map(isb ? L : 0, b);
        u.pm = isb ? b.pm : Base::nM; u.pn = isb ? b.pn : (j % Base::nN); u.split = isb ? 0 : (j / Base::nN); u.nt = isb ? Base::ntk : ntS;
        return isb || j < Base::nN * NS;
    }
    __device__ __forceinline__ void a_ready(const Unit&) const {}
    __device__ __forceinline__ void done(const Unit&) const {}
};

__device__ __forceinline__ unsigned cvt_pk_bf16(float lo, float hi) { unsigned r; asm volatile("v_cvt_pk_bf16_f32 %0, %1, %2" : "=v"(r) : "v"(lo), "v"(hi)); return r; }
template <int ACT  , int ID = 0  > struct EpiBf16 {
    static constexpr bool PERM = true, AFTER_DRAIN = false;
    bf16_t* O; int ldc;
    __device__ __forceinline__ void operator()(const f32x4 (&acc)[2][2][4][2], const Unit& u, int wr, int wc, int fr, int fq) const {
        asm volatile("" : "+v"(fr), "+v"(fq));
        const int row0 = u.pm * BM + wr * 64 + fr; const int col0 = u.pn * BM + wc * 32 + 8 * fq;
#pragma unroll
        for (int ai = 0; ai < 2; ++ai)
#pragma unroll
            for (int m = 0; m < 4; ++m) { bf16_t* rowp = O + (size_t)(row0 + ai * HALF + m * 16) * ldc + col0;
#pragma unroll
                for (int bj = 0; bj < 2; ++bj) { f32x4 v0 = acc[ai][bj][m][0], v1 = acc[ai][bj][m][1];
                    if (ACT == 1) {
#pragma unroll
                        for (int e = 0; e < 4; ++e) { const float a = fmaxf(v0[e], 0.f), b = fmaxf(v1[e], 0.f); v0[e] = a * a; v1[e] = b * b; } }
                    u32x4 w; w.x = cvt_pk_bf16(v0[0], v0[1]); w.y = cvt_pk_bf16(v0[2], v0[3]); w.z = cvt_pk_bf16(v1[0], v1[1]); w.w = cvt_pk_bf16(v1[2], v1[3]);
                    *(u32x4*)(rowp + bj * HALF) = w; } }
    }
};
template <int ID = 0> struct EpiRes {
    static constexpr bool PERM = false, AFTER_DRAIN = false;
    const float* srcP; float* dst; float* part;
    __device__ __forceinline__ void operator()(const f32x4 (&acc)[2][2][4][2], const Unit& u, int wr, int wc, int fr, int fq) const {
        asm volatile("" : "+v"(fr), "+v"(fq));
        const bool sp = u.pm >= 32;
        float* wb = (sp ? part + (size_t)u.split * (BM * 2048) : dst + (size_t)u.pm * (BM * 2048)) + (u.pn * BM + wc * 32 + 4 * fq);
        const float* sb = (srcP != nullptr && !sp) ? srcP + (size_t)u.pm * (BM * 2048) + (u.pn * BM + wc * 32 + 4 * fq) : wb;
#pragma unroll
        for (int ai = 0; ai < 2; ++ai)
#pragma unroll
            for (int m = 0; m < 4; ++m) { const int off = (ai * HALF + wr * 64 + m * 16 + fr) * 2048;
                f32x4 v[2][2];
#pragma unroll
                for (int bj = 0; bj < 2; ++bj)
#pragma unroll
                    for (int n = 0; n < 2; ++n) v[bj][n] = (f32x4){0.f, 0.f, 0.f, 0.f};
                if (!sp) {
#pragma unroll
                    for (int bj = 0; bj < 2; ++bj)
#pragma unroll
                        for (int n = 0; n < 2; ++n) v[bj][n] = *(const f32x4*)(sb + off + bj * HALF + n * 16);
                }
#pragma unroll
                for (int bj = 0; bj < 2; ++bj)
#pragma unroll
                    for (int n = 0; n < 2; ++n) *(f32x4*)(wb + off + bj * HALF + n * 16) = v[bj][n] + acc[ai][bj][m][n];
                asm volatile("" ::: "memory"); }
    }
};

template <class Epi, class Sched, bool ALIGN_EPI = false, bool SP2 = false>
__device__ __forceinline__ void gemm_phase(PG8_LAS unsigned char* lds, const Gemm g, const Sched& S, const Epi& E) {
    int tid_ = threadIdx.x; asm volatile("" : "+v"(tid_)); const int tid = tid_, wid = __builtin_amdgcn_readfirstlane(tid >> 6), lane = tid & 63, wr = wid >> 2, wc = wid & 3, fr = lane & 15, fq = lane >> 4;
    constexpr int K = Sched::KDIM;
    unsigned voffA[2], voffB[2];
#pragma unroll
    for (int i = 0; i < 2; ++i) { int R, C; stage_rc(tid * 16 + i * 8192, R, C); const int Rb = Epi::PERM ? ((R & ~31) + perm32(R & 31)) : R;
        voffA[i] = (unsigned)(R * K + C) * 2u; voffB[i] = (unsigned)(Rb * K + C) * 2u; }
    const size_t kstep = (size_t)(BK * 2);
    const size_t hstep = (size_t)HALF * K * 2;
    const size_t tstep = 2 * hstep;
    const unsigned ldsw = (unsigned)wid * 1024u;
    const int aoff = lds_byte(wr * 64 + fr, fq * 8), boff = lds_byte(wc * 32 + fr, fq * 8);
#define PG8_SA(b, h) (((b) * 2 + (h)) * HTB)
#define PG8_SB(b, h) ((4 + (b) * 2 + (h)) * HTB)
#define PG8_STAGE(bufoff, gbase, voff) do { _Pragma("unroll") for (int _i = 0; _i < 2; ++_i) \
        __builtin_amdgcn_global_load_lds((const unsigned*)((const char*)(gbase) + (voff)[_i]), (PG8_LAS unsigned*)(lds + (bufoff) + ldsw + _i * 8192), 16, 0, 0); } while (0)
#define PG8_LDA(dst, b, h) do { _Pragma("unroll") for (int m = 0; m < 4; ++m) _Pragma("unroll") for (int k = 0; k < 2; ++k) dst[m][k] = *(const PG8_LAS bf16x8*)(lds + PG8_SA(b, h) + aoff + m * 2048 + k * 1024); } while (0)
#define PG8_LDB(dst, b, h) do { _Pragma("unroll") for (int n = 0; n < 2; ++n) _Pragma("unroll") for (int k = 0; k < 2; ++k) dst[n][k] = *(const PG8_LAS bf16x8*)(lds + PG8_SB(b, h) + boff + n * 2048 + k * 1024); } while (0)
#define PG8_MMA(ai, bj, At, Bt) do { __builtin_amdgcn_s_setprio(1); _Pragma("unroll") for (int m = 0; m < 4; ++m) _Pragma("unroll") for (int n = 0; n < 2; ++n) _Pragma("unroll") for (int k = 0; k < 2; ++k) \
        acc[ai][bj][m][n] = __builtin_amdgcn_mfma_f32_16x16x32_bf16(Bt[n][k], At[m][k], acc[ai][bj][m][n], 0, 0, 0); __builtin_amdgcn_s_setprio(0); } while (0)
#define PG8_WAIT_V(n) asm volatile("s_waitcnt vmcnt(" #n ")" ::: "memory")
#define PG8_WAIT_L(n) asm volatile("s_waitcnt lgkmcnt(" #n ")" ::: "memory")
#define PG8_BAR __builtin_amdgcn_s_barrier()
#define PG8_SCHED __builtin_amdgcn_sched_barrier(0)
    Unit cur, nxt; int ui = 0;
    if (!S.next(0, cur)) return;
    f32x4 acc[2][2][4][2];
#pragma unroll
    for (int a = 0; a < 2; ++a)
#pragma unroll
        for (int b = 0; b < 2; ++b)
#pragma unroll
            for (int m = 0; m < 4; ++m)
#pragma unroll
                for (int n = 0; n < 2; ++n) acc[a][b][m][n] = (f32x4){0.f, 0.f, 0.f, 0.f};
    bf16x8 At[4][2], B0[2][2], B1[2][2];
    const char* cA = (const char*)g.A + (size_t)cur.pm * tstep + (size_t)(cur.split * cur.nt) * kstep; const char* cB = (const char*)g.Bt + (size_t)cur.pn * tstep + (size_t)(cur.split * cur.nt) * kstep;
    S.a_ready(cur);
    if constexpr (SP2) {
        PG8_STAGE(PG8_SB(0, 0), cB, voffB); PG8_STAGE(PG8_SB(0, 1), cB + hstep, voffB); PG8_STAGE(PG8_SA(0, 0), cA, voffA); PG8_STAGE(PG8_SA(0, 1), cA + hstep, voffA);
        if (wr == 1) PG8_BAR;
        PG8_WAIT_V(2); PG8_BAR;
        PG8_STAGE(PG8_SB(1, 0), cB + kstep, voffB); PG8_STAGE(PG8_SA(1, 0), cA + kstep, voffA); PG8_STAGE(PG8_SB(1, 1), cB + hstep + kstep, voffB);
        PG8_WAIT_V(6); PG8_BAR;
    } else {
        PG8_STAGE(PG8_SB(0, 0), cB, voffB); PG8_STAGE(PG8_SA(0, 0), cA, voffA); PG8_STAGE(PG8_SB(0, 1), cB + hstep, voffB); PG8_STAGE(PG8_SA(0, 1), cA + hstep, voffA);
        if (wr == 1) PG8_BAR;
        PG8_WAIT_V(4); PG8_BAR;
        PG8_STAGE(PG8_SB(1, 0), cB + kstep, voffB); PG8_STAGE(PG8_SA(1, 0), cA + kstep, voffA); PG8_STAGE(PG8_SB(1, 1), cB + hstep + kstep, voffB);
        PG8_WAIT_V(6); PG8_BAR;
    }
    for (;;) {
        const bool has_next = S.next(ui + 1, nxt);
        const char* nA = has_next ? (const char*)g.A + (size_t)nxt.pm * tstep + (size_t)(nxt.split * nxt.nt) * kstep : cA; const char* nB = has_next ? (const char*)g.Bt + (size_t)nxt.pn * tstep + (size_t)(nxt.split * nxt.nt) * kstep : cB;
        const int nt = cur.nt;
        for (int t = 0; t < nt; t += 2) {
            const bool last = (t == nt - 2);
            const char* a1 = cA + (size_t)(t + 1) * kstep;
            const char* a2 = last ? nA : cA + (size_t)(t + 2) * kstep; const char* b2 = last ? nB : cB + (size_t)(t + 2) * kstep;
            const char* a3 = a2 + kstep; const char* b3 = b2 + kstep;
            if (last && has_next) S.a_ready(nxt);
            if constexpr (SP2) {
            PG8_LDB(B0, 0, 0); PG8_LDB(B1, 0, 1); PG8_SCHED; PG8_LDA(At, 0, 0); PG8_STAGE(PG8_SA(1, 1), a1 + hstep, voffA);
            PG8_WAIT_V(8); PG8_WAIT_L(0); PG8_BAR; PG8_MMA(0, 0, At, B0); PG8_MMA(0, 1, At, B1); PG8_BAR; PG8_SCHED;
            PG8_LDA(At, 0, 1); PG8_STAGE(PG8_SB(0, 0), b2, voffB); PG8_STAGE(PG8_SB(0, 1), b2 + hstep, voffB); PG8_STAGE(PG8_SA(0, 0), a2, voffA);
            PG8_WAIT_V(8); PG8_WAIT_L(0); PG8_BAR; PG8_MMA(1, 0, At, B0); PG8_MMA(1, 1, At, B1); PG8_BAR; PG8_SCHED;
            PG8_LDB(B0, 1, 0); PG8_LDB(B1, 1, 1); PG8_SCHED; PG8_LDA(At, 1, 0); PG8_STAGE(PG8_SA(0, 1), a2 + hstep, voffA);
            PG8_WAIT_V(8); PG8_WAIT_L(0); PG8_BAR; PG8_MMA(0, 0, At, B0); PG8_MMA(0, 1, At, B1); PG8_BAR; PG8_SCHED;
            PG8_LDA(At, 1, 1); PG8_STAGE(PG8_SB(1, 0), b3, voffB); PG8_STAGE(PG8_SB(1, 1), b3 + hstep, voffB); PG8_STAGE(PG8_SA(1, 0), a3, voffA);
            PG8_WAIT_V(8); PG8_WAIT_L(0); PG8_BAR; PG8_MMA(1, 0, At, B0); PG8_MMA(1, 1, At, B1); PG8_BAR; PG8_SCHED;
            } else {
            PG8_LDB(B0, 0, 0); PG8_SCHED; PG8_LDA(At, 0, 0); PG8_STAGE(PG8_SA(1, 1), a1 + hstep, voffA);
            PG8_WAIT_L(8); PG8_BAR; PG8_WAIT_L(0); PG8_MMA(0, 0, At, B0); PG8_BAR; PG8_SCHED;
            PG8_LDB(B1, 0, 1); PG8_STAGE(PG8_SB(0, 0), b2, voffB);
            PG8_BAR; PG8_WAIT_L(0); PG8_MMA(0, 1, At, B1); PG8_BAR;
            PG8_LDA(At, 0, 1); PG8_STAGE(PG8_SA(0, 0), a2, voffA);
            PG8_BAR; PG8_WAIT_L(0); PG8_MMA(1, 0, At, B0); PG8_BAR; PG8_SCHED;
            PG8_STAGE(PG8_SB(0, 1), b2 + hstep, voffB);
            PG8_WAIT_V(6); PG8_BAR; PG8_MMA(1, 1, At, B1); PG8_BAR;
            PG8_LDB(B0, 1, 0); PG8_SCHED; PG8_LDA(At, 1, 0); PG8_STAGE(PG8_SA(0, 1), a2 + hstep, voffA);
            PG8_WAIT_L(8); PG8_BAR; PG8_WAIT_L(0); PG8_MMA(0, 0, At, B0); PG8_BAR; PG8_SCHED;
            PG8_LDB(B1, 1, 1); PG8_STAGE(PG8_SB(1, 0), b3, voffB);
            PG8_BAR; PG8_WAIT_L(0); PG8_MMA(0, 1, At, B1); PG8_BAR;
            PG8_LDA(At, 1, 1); PG8_STAGE(PG8_SA(1, 0), a3, voffA);
            PG8_BAR; PG8_WAIT_L(0); PG8_MMA(1, 0, At, B0); PG8_BAR; PG8_SCHED;
            PG8_STAGE(PG8_SB(1, 1), b3 + hstep, voffB);
            PG8_WAIT_V(6); PG8_BAR; PG8_MMA(1, 1, At, B1); PG8_BAR;
            }
        }
        if constexpr (ALIGN_EPI) { if (wr == 0) PG8_BAR; }
        if constexpr (!Epi::AFTER_DRAIN) { E(acc, cur, wr, wc, fr, fq); S.done(cur); }
        if (!has_next) break;
#pragma unroll
        for (int a = 0; a < 2; ++a)
#pragma unroll
            for (int b = 0; b < 2; ++b)
#pragma unroll
                for (int m = 0; m < 4; ++m)
#pragma unroll
                    for (int n = 0; n < 2; ++n) acc[a][b][m][n] = (f32x4){0.f, 0.f, 0.f, 0.f};
        cur = nxt; cA = nA; cB = nB; ++ui;
        if constexpr (ALIGN_EPI) { if (wr == 1) PG8_BAR; }
    }
    PG8_WAIT_V(0);
    if constexpr (!ALIGN_EPI) { if (wr == 0) PG8_BAR; }
    PG8_BAR;
    if constexpr (Epi::AFTER_DRAIN) { E.fused(acc, cur, wr, wc, fr, fq, lds, wid, lane); S.done(cur); }
#undef PG8_SA
#undef PG8_SB
#undef PG8_STAGE
#undef PG8_LDA
#undef PG8_LDB
#undef PG8_MMA
#undef PG8_WAIT_V
#undef PG8_WAIT_L
#undef PG8_BAR
#undef PG8_SCHED
}
}
constexpr int D = 2048, SEQ = 4096, NBATCH = 2, MP = NBATCH * SEQ, DEC_B = 32, DEC_T = 8, MS = DEC_B * DEC_T, M = MP + MS;
constexpr int FF = 8192, NIN = 3 * D, HD = 64, NH = 32, NKV = 4, KVW = NKV * HD, NQKV = NH * HD + 2 * KVW, PAST = 16384, WIN = 128;
constexpr int SKF = WIN + DEC_T;
constexpr int SVP = 144;
constexpr float EPS = 1e-6f, LOG2E = 1.4426950408889634f, QSCALE = 0.125f * LOG2E;
constexpr size_t O_CP = (size_t)M * D, O_CS = O_CP + (size_t)NBATCH * 2 * D, O_KP = O_CS + (size_t)DEC_B * 2 * D, O_VP = O_KP + (size_t)NBATCH * WIN * KVW,
                 O_KS = O_VP + (size_t)NBATCH * WIN * KVW, O_VS = O_KS + (size_t)DEC_B * WIN * KVW;
constexpr size_t MiB = 1u << 20;
constexpr size_t WS_WIN = 0, WS_WOUT = 24 * MiB, WS_WQKV = 32 * MiB, WS_WATT = 42 * MiB, WS_WUP0 = 50 * MiB, WS_WUP1 = 82 * MiB, WS_WDN0 = 114 * MiB, WS_WDN1 = 146 * MiB;
constexpr size_t WS_H = 180 * MiB, WS_R = 214 * MiB, WS_A = WS_R, WS_BCV = WS_R, WS_G = WS_R + 99 * MiB, WS_QKV = WS_R + 132 * MiB  , WS_Q = WS_R + 42 * MiB, WS_O = WS_R + 75 * MiB;
constexpr size_t WS_KP = WS_R + 108 * MiB, WS_VTP = WS_R + 112 * MiB, WS_KS = WS_R + 116 * MiB, WS_VTS = WS_R + 119 * MiB, WS_HX = WS_R + 174 * MiB  , WS_END = WS_HX + 99 * MiB;
static_assert((size_t)8448 * 6144 * 2 <= 99 * MiB && (size_t)8448 * 8192 * 2 <= 132 * MiB && (size_t)8448 * 2560 * 2 <= 42 * MiB && (size_t)8448 * 2048 * 2 <= 33 * MiB, "ws map");
constexpr size_t WS_PART = WS_QKV;
constexpr size_t WS_BAR = 178 * MiB;
constexpr int LDS_RING = 131072, LDS_BYTES = LDS_RING + 64;
constexpr int NTHREADS = 512, NWAVES = 8;

#define LAS __attribute__((address_space(3)))
typedef unsigned short bf16;
typedef float f32x4 __attribute__((ext_vector_type(4)));
typedef unsigned u32x4 __attribute__((ext_vector_type(4)));
typedef unsigned u32x2 __attribute__((ext_vector_type(2)));
typedef short bf16x8 __attribute__((ext_vector_type(8)));
__device__ __forceinline__ float bf2f(unsigned v) { return __uint_as_float(v << 16); }
__device__ __forceinline__ float bflo(unsigned w) { return __uint_as_float(w << 16); }
__device__ __forceinline__ float bfhi(unsigned w) { return __uint_as_float(w & 0xffff0000u); }
__device__ __forceinline__ unsigned pk2(float lo, float hi) { return pg8::cvt_pk_bf16(lo, hi); }
__device__ __forceinline__ float shx(float v, int o, int lane) { return __int_as_float(__builtin_amdgcn_ds_bpermute((lane ^ o) << 2, __float_as_int(v))); }
__device__ __forceinline__ float wave_sum(float v, int lane) {
#pragma unroll
    for (int o = 1; o < 64; o <<= 1) v += shx(v, o, lane);
    return v;
}
__device__ const double ROPE_INV[32] = {1.0, 0.7498942093324559, 0.5623413251903491, 0.4216965034285822, 0.31622776601683794, 0.23713737056616552, 0.1778279410038923, 0.1333521432163324,
    0.1, 0.07498942093324558, 0.05623413251903491, 0.042169650342858224, 0.03162277660168379, 0.023713737056616554, 0.01778279410038923, 0.01333521432163324,
    0.01, 0.007498942093324558, 0.005623413251903491, 0.004216965034285823, 0.0031622776601683794, 0.0023713737056616554, 0.0017782794100389228, 0.001333521432163324,
    0.001, 0.0007498942093324559, 0.0005623413251903491, 0.00042169650342858224, 0.00031622776601683794, 0.00023713737056616554, 0.00017782794100389227, 0.0001333521432163324};

__device__ __forceinline__ void transpose_item(const float* __restrict__ W, const float* __restrict__ gain, bf16* __restrict__ WT, int K, int N, int item, LAS unsigned* T, int lane) {
    const int nblk = N >> 6, kb = item / nblk, nb = item - kb * nblk, k0 = kb * 64, n0 = nb * 64;
    const int j = lane & 15, g = lane >> 4;
    const float* src = W + (size_t)(k0 + 2 * g) * N + n0 + 4 * j;
    f32x4 a[8], b[8];
#pragma unroll
    for (int i = 0; i < 8; ++i) { a[i] = *(const f32x4*)(src + (size_t)(8 * i) * N); b[i] = *(const f32x4*)(src + (size_t)(8 * i + 1) * N); }
    if (gain != nullptr) {
#pragma unroll
        for (int i = 0; i < 8; ++i) { const float ga = gain[k0 + 8 * i + 2 * g], gb = gain[k0 + 8 * i + 2 * g + 1]; a[i] = a[i] * ga; b[i] = b[i] * gb; }
    }
#pragma unroll
    for (int i = 0; i < 8; ++i) {
        const int r = 4 * i + g;
#pragma unroll
        for (int e = 0; e < 4; ++e) T[(4 * j + e) * 33 + r] = pk2(a[i][e], b[i][e]);
    }
    asm volatile("s_waitcnt lgkmcnt(0)" ::: "memory");
    const int c = lane & 7;
#pragma unroll
    for (int q = 0; q < 8; ++q) {
        const int n = (lane >> 3) + 8 * q; const LAS unsigned* s = T + n * 33 + 4 * c;
        u32x4 o; o.x = s[0]; o.y = s[1]; o.z = s[2]; o.w = s[3];
        *(u32x4*)(WT + (size_t)(n0 + n) * K + k0 + 8 * c) = o;
    }
    asm volatile("s_waitcnt lgkmcnt(0)" ::: "memory");
}

__device__ __forceinline__ void rms_rows(const float* srcP, const float* srcS, bf16* __restrict__ H, float* copyS, const float* part, int nsplit, int gw, int ngw, int lane) {
    for (int row = gw; row < M; row += ngw) {
        const float* xr = (row < MP) ? srcP + (size_t)row * D : srcS + (size_t)(row - MP) * D;
        f32x4 v[8]; float ss = 0.f;
#pragma unroll
        for (int j = 0; j < 4; ++j) { v[2 * j] = *(const f32x4*)(xr + j * 512 + lane * 8); v[2 * j + 1] = *(const f32x4*)(xr + j * 512 + lane * 8 + 4); }
        if (part != nullptr && row >= MP) {
            const float* pr = part + (size_t)(row - MP) * D;
            for (int s = 0; s < nsplit; ++s, pr += (size_t)MS * D) {
#pragma unroll
                for (int j = 0; j < 4; ++j) { v[2 * j] += *(const f32x4*)(pr + j * 512 + lane * 8); v[2 * j + 1] += *(const f32x4*)(pr + j * 512 + lane * 8 + 4); }
            }
        }
#pragma unroll
        for (int j = 0; j < 8; ++j) ss += (v[j][0] * v[j][0] + v[j][1] * v[j][1]) + (v[j][2] * v[j][2] + v[j][3] * v[j][3]);
        ss = wave_sum(ss, lane);
        const float rstd = 1.0f / sqrtf(ss * (1.0f / D) + EPS);
        bf16* hr = H + (size_t)row * D;
#pragma unroll
        for (int j = 0; j < 4; ++j) { const f32x4 p = v[2 * j] * rstd, q = v[2 * j + 1] * rstd; u32x4 o; o.x = pk2(p[0], p[1]); o.y = pk2(p[2], p[3]); o.z = pk2(q[0], q[1]); o.w = pk2(q[2], q[3]);
            *(u32x4*)(hr + j * 512 + lane * 8) = o; }
        if (copyS != nullptr && row >= MP) { float* cr = copyS + (size_t)(row - MP) * D;
#pragma unroll
            for (int j = 0; j < 4; ++j) { *(f32x4*)(cr + j * 512 + lane * 8) = v[2 * j]; *(f32x4*)(cr + j * 512 + lane * 8 + 4) = v[2 * j + 1]; } }
    }
}

__device__ __forceinline__ void reduce_sample(float* __restrict__ yS, const float* __restrict__ part, int nsplit, int gw, int ngw, int lane) {
    for (int row = gw; row < MS; row += ngw) {
        float* yr = yS + (size_t)row * D; f32x4 v[8];
#pragma unroll
        for (int j = 0; j < 4; ++j) { v[2 * j] = *(const f32x4*)(yr + j * 512 + lane * 8); v[2 * j + 1] = *(const f32x4*)(yr + j * 512 + lane * 8 + 4); }
        const float* pr = part + (size_t)row * D;
        for (int s = 0; s < nsplit; ++s, pr += (size_t)MS * D) {
#pragma unroll
            for (int j = 0; j < 4; ++j) { v[2 * j] += *(const f32x4*)(pr + j * 512 + lane * 8); v[2 * j + 1] += *(const f32x4*)(pr + j * 512 + lane * 8 + 4); }
        }
#pragma unroll
        for (int j = 0; j < 4; ++j) { *(f32x4*)(yr + j * 512 + lane * 8) = v[2 * j]; *(f32x4*)(yr + j * 512 + lane * 8 + 4) = v[2 * j + 1]; }
    }
}

__device__ __forceinline__ void unpack8(const u32x4 w, float (&f)[8]) { f[0] = bflo(w.x); f[1] = bfhi(w.x); f[2] = bflo(w.y); f[3] = bfhi(w.y); f[4] = bflo(w.z); f[5] = bfhi(w.z); f[6] = bflo(w.w); f[7] = bfhi(w.w); }
__device__ __forceinline__ void conv_phase(const bf16* __restrict__ bcv, const float* __restrict__ state, const float* __restrict__ wconv, bf16* __restrict__ G, float* __restrict__ out_cp, float* __restrict__ out_cs, int gtid, int nthreads) {
    for (int item = gtid; item < (M / 8) * 256; item += nthreads) {
        const int rb = item >> 8, dc = item & 255, d0 = dc * 8, r0 = rb * 8;
        float w0[8], w1[8], w2[8], up2[8], up1[8];
        { const f32x4 a = *(const f32x4*)(wconv + d0), b = *(const f32x4*)(wconv + d0 + 4), c = *(const f32x4*)(wconv + D + d0), d = *(const f32x4*)(wconv + D + d0 + 4), e = *(const f32x4*)(wconv + 2 * D + d0), f = *(const f32x4*)(wconv + 2 * D + d0 + 4);
#pragma unroll
          for (int k = 0; k < 4; ++k) { w0[k] = a[k]; w0[4 + k] = b[k]; w1[k] = c[k]; w1[4 + k] = d[k]; w2[k] = e[k]; w2[4 + k] = f[k]; } }
        const bool samp = r0 >= MP; const int sb = (r0 - MP) >> 3;
        if (samp) {
            const f32x4 a = *(const f32x4*)(state + (size_t)(sb * 2) * D + d0), b = *(const f32x4*)(state + (size_t)(sb * 2) * D + d0 + 4), c = *(const f32x4*)(state + (size_t)(sb * 2 + 1) * D + d0), d = *(const f32x4*)(state + (size_t)(sb * 2 + 1) * D + d0 + 4);
#pragma unroll
            for (int k = 0; k < 4; ++k) { up2[k] = a[k]; up2[4 + k] = b[k]; up1[k] = c[k]; up1[4 + k] = d[k]; }
        } else if ((r0 & (SEQ - 1)) == 0) {
#pragma unroll
            for (int k = 0; k < 8; ++k) { up2[k] = 0.f; up1[k] = 0.f; }
        } else {
            float c[8], v[8];
            unpack8(*(const u32x4*)(bcv + (size_t)(r0 - 2) * NIN + D + d0), c); unpack8(*(const u32x4*)(bcv + (size_t)(r0 - 2) * NIN + 2 * D + d0), v);
#pragma unroll
            for (int k = 0; k < 8; ++k) up2[k] = c[k] * v[k];
            unpack8(*(const u32x4*)(bcv + (size_t)(r0 - 1) * NIN + D + d0), c); unpack8(*(const u32x4*)(bcv + (size_t)(r0 - 1) * NIN + 2 * D + d0), v);
#pragma unroll
            for (int k = 0; k < 8; ++k) up1[k] = c[k] * v[k];
        }
#pragma unroll
        for (int rr = 0; rr < 8; ++rr) {
            const bf16* rp = bcv + (size_t)(r0 + rr) * NIN + d0;
            float bg[8], c[8], v[8], u[8], g[8];
            unpack8(*(const u32x4*)rp, bg); unpack8(*(const u32x4*)(rp + D), c); unpack8(*(const u32x4*)(rp + 2 * D), v);
#pragma unroll
            for (int k = 0; k < 8; ++k) { u[k] = c[k] * v[k]; g[k] = bg[k] * (w0[k] * up2[k] + w1[k] * up1[k] + w2[k] * u[k]); up2[k] = up1[k]; up1[k] = u[k]; }
            u32x4 o; o.x = pk2(g[0], g[1]); o.y = pk2(g[2], g[3]); o.z = pk2(g[4], g[5]); o.w = pk2(g[6], g[7]);
            *(u32x4*)(G + (size_t)(r0 + rr) * D + d0) = o;
        }
        float* op = nullptr;
        if (samp) op = out_cs + (size_t)(sb * 2) * D + d0;
        else if ((r0 & (SEQ - 1)) == SEQ - 8) op = out_cp + (size_t)((r0 >> 12) * 2) * D + d0;
        if (op != nullptr) {
            *(f32x4*)op = (f32x4){up2[0], up2[1], up2[2], up2[3]}; *(f32x4*)(op + 4) = (f32x4){up2[4], up2[5], up2[6], up2[7]};
            *(f32x4*)(op + D) = (f32x4){up1[0], up1[1], up1[2], up1[3]}; *(f32x4*)(op + D + 4) = (f32x4){up1[4], up1[5], up1[6], up1[7]};
        }
    }
}

struct PostArgs { const bf16* raw; const float* qn; const float* kn; const float* cache_k; const float* cache_v; bf16* Q; bf16* KP; bf16* VTP; bf16* KS; bf16* VTS; float* out; };
__device__ __forceinline__ void post_phase(const PostArgs& P, int gw, int ngw, int lane, int gtid, int nthreads, int parts  ) {
    if (parts & 1) {
        const int l8 = lane & 7, l4 = lane & 3; const bool first = l8 < 4;
        double inv[8]; float gq[8], gk[8];
#pragma unroll
        for (int e = 0; e < 8; ++e) { inv[e] = ROPE_INV[8 * l4 + e] * 0.15915494309189535; gq[e] = P.qn[8 * l8 + e]; gk[e] = P.kn[8 * l8 + e]; }
        for (int row = gw; row < M; row += ngw) {
            const bool samp = row >= MP; int b, t, pos;
            if (!samp) { b = row >> 12; t = row & (SEQ - 1); pos = t; } else { b = (row - MP) >> 3; t = (row - MP) & 7; pos = PAST + t; }
            const bf16* src = P.raw + (size_t)row * NQKV + 8 * lane;
            u32x4 ch[5];
#pragma unroll
            for (int j = 0; j < 5; ++j) ch[j] = *(const u32x4*)(src + 512 * j);
            float cs[8], sn[8];
#pragma unroll
            for (int e = 0; e < 8; ++e) { const double rev = (double)pos * inv[e]; const float fr = (float)(rev - __builtin_rint(rev)); sn[e] = __builtin_amdgcn_sinf(fr); cs[e] = __builtin_amdgcn_cosf(fr); }
#pragma unroll
            for (int j = 0; j < 5; ++j) {
                float x[8], o[8]; unpack8(ch[j], x);
                float ss = 0.f;
#pragma unroll
                for (int e = 0; e < 8; ++e) ss += x[e] * x[e];
                ss += shx(ss, 1, lane); ss += shx(ss, 2, lane); ss += shx(ss, 4, lane);
                const float rstd = 1.0f / sqrtf(ss * (1.0f / HD) + EPS);
#pragma unroll
                for (int e = 0; e < 8; ++e) { const float y = x[e] * rstd * (j < 4 ? gq[e] : gk[e]); const float py = shx(y, 4, lane); o[e] = first ? y * cs[e] - py * sn[e] : y * cs[e] + py * sn[e]; }
                if (j < 4) {
                    u32x4 w; w.x = pk2(o[0] * QSCALE, o[1] * QSCALE); w.y = pk2(o[2] * QSCALE, o[3] * QSCALE); w.z = pk2(o[4] * QSCALE, o[5] * QSCALE); w.w = pk2(o[6] * QSCALE, o[7] * QSCALE);
                    *(u32x4*)(P.Q + (size_t)row * D + 512 * j + 8 * lane) = w;
                } else if (lane < 32) {
                    u32x4 w; w.x = pk2(o[0], o[1]); w.y = pk2(o[2], o[3]); w.z = pk2(o[4], o[5]); w.w = pk2(o[6], o[7]);
                    float* op = nullptr;
                    if (!samp) { *(u32x4*)(P.KP + (size_t)row * KVW + 8 * lane) = w; if (t >= SEQ - WIN) op = P.out + O_KP + (size_t)(b * WIN + (t - (SEQ - WIN))) * KVW + 8 * lane; }
                    else { *(u32x4*)(P.KS + ((size_t)b * SKF + WIN + t) * KVW + 8 * lane) = w; op = P.out + O_KS + (size_t)(b * WIN + (WIN - DEC_T) + t) * KVW + 8 * lane; }
                    if (op != nullptr) { *(f32x4*)op = (f32x4){o[0], o[1], o[2], o[3]}; *(f32x4*)(op + 4) = (f32x4){o[4], o[5], o[6], o[7]}; }
                }
            }
        }
    }
    for (int item = (parts & 1) ? gw : M; item < M / 8; item += ngw) {
        const int r0 = item * 8; const int c4 = 4 * lane, kvh = c4 >> 6, d = c4 & 63;
        float v[8][4];
#pragma unroll
        for (int rr = 0; rr < 8; ++rr) { const u32x2 w = *(const u32x2*)(P.raw + (size_t)(r0 + rr) * NQKV + NH * HD + KVW + c4); v[rr][0] = bflo(w.x); v[rr][1] = bfhi(w.x); v[rr][2] = bflo(w.y); v[rr][3] = bfhi(w.y); }
        if (r0 < MP) {
            const int b = r0 >> 12, t0 = r0 & (SEQ - 1);
#pragma unroll
            for (int e = 0; e < 4; ++e) { u32x4 o; o.x = pk2(v[0][e], v[1][e]); o.y = pk2(v[2][e], v[3][e]); o.z = pk2(v[4][e], v[5][e]); o.w = pk2(v[6][e], v[7][e]);
                *(u32x4*)(P.VTP + ((size_t)(b * NKV + kvh) * HD + d + e) * SEQ + t0) = o; }
            if (t0 >= SEQ - WIN) {
#pragma unroll
                for (int rr = 0; rr < 8; ++rr) *(f32x4*)(P.out + O_VP + (size_t)(b * WIN + (t0 + rr - (SEQ - WIN))) * KVW + c4) = (f32x4){v[rr][0], v[rr][1], v[rr][2], v[rr][3]};
            }
        } else {
            const int b = (r0 - MP) >> 3;
#pragma unroll
            for (int e = 0; e < 4; ++e) { u32x4 o; o.x = pk2(v[0][e], v[1][e]); o.y = pk2(v[2][e], v[3][e]); o.z = pk2(v[4][e], v[5][e]); o.w = pk2(v[6][e], v[7][e]);
                bf16* vp = P.VTS + ((size_t)(b * NKV + kvh) * HD + d + e) * SVP; *(u32x4*)(vp + WIN) = o; *(u32x4*)(vp + WIN + 8) = (u32x4){0u, 0u, 0u, 0u}; }
#pragma unroll
            for (int rr = 0; rr < 8; ++rr) *(f32x4*)(P.out + O_VS + (size_t)(b * WIN + (WIN - DEC_T) + rr) * KVW + c4) = (f32x4){v[rr][0], v[rr][1], v[rr][2], v[rr][3]};
        }
    }
    for (int idx = (parts & 2) ? gtid : DEC_B * WIN * (KVW / 4); idx < DEC_B * WIN * (KVW / 4); idx += nthreads) {
        const int f = idx & (WIN - 1), c4 = ((idx >> 7) & 63) * 4, b = idx >> 13, kvh = c4 >> 6, d = c4 & 63;
        const f32x4 kc = *(const f32x4*)(P.cache_k + ((size_t)b * WIN + f) * KVW + c4), vc = *(const f32x4*)(P.cache_v + ((size_t)b * WIN + f) * KVW + c4);
        u32x2 kk; kk.x = pk2(kc[0], kc[1]); kk.y = pk2(kc[2], kc[3]);
        *(u32x2*)(P.KS + ((size_t)b * SKF + f) * KVW + c4) = kk;
#pragma unroll
        for (int e = 0; e < 4; ++e) P.VTS[((size_t)(b * NKV + kvh) * HD + d + e) * SVP + f] = (bf16)pk2(vc[e], 0.f);
        if (f >= DEC_T) { *(f32x4*)(P.out + O_KS + ((size_t)b * WIN + f - DEC_T) * KVW + c4) = kc; *(f32x4*)(P.out + O_VS + ((size_t)b * WIN + f - DEC_T) * KVW + c4) = vc; }
    }
}

constexpr int KROW = 144, VROW = 528, ATT_K_BYTES = 256 * KROW;
__device__ __forceinline__ void attn_phase(LAS unsigned char* lds, const bf16* __restrict__ Q, const bf16* __restrict__ KP, const bf16* __restrict__ VTP, const bf16* __restrict__ KS, const bf16* __restrict__ VTS,
                                           const float* __restrict__ sinks, bf16* __restrict__ O, int G) {
    int tid_ = threadIdx.x; asm volatile("" : "+v"(tid_)); const int tid = tid_, lane = tid & 63, wid = __builtin_amdgcn_readfirstlane(tid >> 6), fr = lane & 15, fq = lane >> 4;
    LAS unsigned char* Ksm = lds; LAS unsigned char* Vsm = lds + ATT_K_BYTES;
    for (int u = blockIdx.x; u < 256; u += G) {
        int nq, qrow0, f0, nk, nkv, kvh, vpitch; const bf16* kbase; const bf16* vbase;
        if (u < 256) { const int b = u >> 7, n = u & 31; kvh = (u >> 5) & 3; nq = 128; qrow0 = b * SEQ + n * 128; f0 = (n == 0) ? 128 : 0; nk = 256; nkv = 256;
            kbase = KP + ((long)(b * SEQ) + (long)(n - 1) * 128) * KVW + kvh * 64; vbase = VTP + (long)((b * NKV + kvh) * HD) * SEQ + (long)(n - 1) * 128; vpitch = SEQ; }
        else { const int s = u - 256, b = s >> 2; kvh = s & 3; nq = DEC_T; qrow0 = MP + b * DEC_T; f0 = 0; nk = SKF; nkv = SVP;
            kbase = KS + (long)b * SKF * KVW + kvh * 64; vbase = VTS + (long)((b * NKV + kvh) * HD) * SVP; vpitch = SVP; }
#pragma unroll
        for (int i = 0; i < 4; ++i) { const int id = tid + NTHREADS * i, f = id >> 3, c = id & 7; u32x4 v = (u32x4){0u, 0u, 0u, 0u};
            if (f >= f0 && f < nk) v = *(const u32x4*)(kbase + (long)f * KVW + c * 8);
            *(LAS u32x4*)(Ksm + f * KROW + c * 16) = v; }
#pragma unroll
        for (int i = 0; i < 4; ++i) { const int id = tid + NTHREADS * i, d = id >> 5, c = id & 31; u32x4 v = (u32x4){0u, 0u, 0u, 0u};
            if (8 * c >= f0 && 8 * c < nkv) v = *(const u32x4*)(vbase + (long)d * vpitch + 8 * c);
            *(LAS u32x4*)(Vsm + d * VROW + c * 16) = v; }
        __syncthreads();
        const int h = kvh * 8 + wid; const float sink2 = sinks[h] * LOG2E;
        const int nsub = (nq + 15) >> 4;
        for (int sp = 0; sp < 4; ++sp) {
            const int iA = 32 * sp + fr, iB = iA + 16, ktb = 2 * sp;
            const bf16* qpA = Q + (size_t)(qrow0 + iA) * D + h * 64 + 8 * fq; const bf16* qpB = qpA + 16 * D;
            const bf16x8 qA0 = *(const bf16x8*)qpA, qA1 = *(const bf16x8*)(qpA + 32), qB0 = *(const bf16x8*)qpB, qB1 = *(const bf16x8*)(qpB + 32);
            f32x4 sA[10], sB[10];
#pragma unroll
            for (int j = 0; j < 10; ++j) { const LAS unsigned char* kr = Ksm + (16 * (ktb + j) + fr) * KROW + fq * 16;
                const bf16x8 a0 = *(const LAS bf16x8*)kr, a1 = *(const LAS bf16x8*)(kr + 64);
                f32x4 accA = (f32x4){0.f, 0.f, 0.f, 0.f}, accB = accA;
                accA = __builtin_amdgcn_mfma_f32_16x16x32_bf16(a0, qA0, accA, 0, 0, 0); accB = __builtin_amdgcn_mfma_f32_16x16x32_bf16(a0, qB0, accB, 0, 0, 0);
                accA = __builtin_amdgcn_mfma_f32_16x16x32_bf16(a1, qA1, accA, 0, 0, 0); accB = __builtin_amdgcn_mfma_f32_16x16x32_bf16(a1, qB1, accB, 0, 0, 0); sA[j] = accA; sB[j] = accB; }
            float mxA = -INFINITY, mxB = -INFINITY;
#pragma unroll
            for (int j = 0; j < 10; ++j)
#pragma unroll
                for (int e = 0; e < 4; ++e) { const int f = 16 * (ktb + j) + 4 * fq + e;
                    const bool okA = (f >= iA + 1) && (f <= iA + WIN) && (f >= f0), okB = (f >= iB + 1) && (f <= iB + WIN) && (f >= f0);
                    sA[j][e] = okA ? sA[j][e] : -INFINITY; mxA = fmaxf(mxA, sA[j][e]); sB[j][e] = okB ? sB[j][e] : -INFINITY; mxB = fmaxf(mxB, sB[j][e]); }
            mxA = fmaxf(mxA, shx(mxA, 16, lane)); mxB = fmaxf(mxB, shx(mxB, 16, lane)); mxA = fmaxf(mxA, shx(mxA, 32, lane)); mxB = fmaxf(mxB, shx(mxB, 32, lane));
            mxA = fmaxf(mxA, sink2); mxB = fmaxf(mxB, sink2);
            float lA = 0.f, lB = 0.f;
#pragma unroll
            for (int j = 0; j < 10; ++j)
#pragma unroll
                for (int e = 0; e < 4; ++e) { const float pA = __builtin_amdgcn_exp2f(sA[j][e] - mxA), pB = __builtin_amdgcn_exp2f(sB[j][e] - mxB); sA[j][e] = pA; lA += pA; sB[j][e] = pB; lB += pB; }
            lA += shx(lA, 16, lane); lB += shx(lB, 16, lane); lA += shx(lA, 32, lane); lB += shx(lB, 32, lane);
            lA += __builtin_amdgcn_exp2f(sink2 - mxA); lB += __builtin_amdgcn_exp2f(sink2 - mxB);
            f32x4 oA[4], oB[4];
#pragma unroll
            for (int dt = 0; dt < 4; ++dt) { oA[dt] = (f32x4){0.f, 0.f, 0.f, 0.f}; oB[dt] = oA[dt]; }
#pragma unroll
            for (int jp = 0; jp < 5; ++jp) {
                u32x4 pw; pw.x = pk2(sA[2 * jp][0], sA[2 * jp][1]); pw.y = pk2(sA[2 * jp][2], sA[2 * jp][3]); pw.z = pk2(sA[2 * jp + 1][0], sA[2 * jp + 1][1]); pw.w = pk2(sA[2 * jp + 1][2], sA[2 * jp + 1][3]);
                const bf16x8 pbA = __builtin_bit_cast(bf16x8, pw);
                pw.x = pk2(sB[2 * jp][0], sB[2 * jp][1]); pw.y = pk2(sB[2 * jp][2], sB[2 * jp][3]); pw.z = pk2(sB[2 * jp + 1][0], sB[2 * jp + 1][1]); pw.w = pk2(sB[2 * jp + 1][2], sB[2 * jp + 1][3]);
                const bf16x8 pbB = __builtin_bit_cast(bf16x8, pw);
#pragma unroll
                for (int dt = 0; dt < 4; ++dt) { const LAS unsigned char* vr = Vsm + (16 * dt + fr) * VROW + (16 * (ktb + 2 * jp) + 4 * fq) * 2;
                    const u32x2 lo = *(const LAS u32x2*)vr, hi = *(const LAS u32x2*)(vr + 32);
                    const bf16x8 a = __builtin_bit_cast(bf16x8, (u32x4){lo.x, lo.y, hi.x, hi.y});
                    oA[dt] = __builtin_amdgcn_mfma_f32_16x16x32_bf16(a, pbA, oA[dt], 0, 0, 0); oB[dt] = __builtin_amdgcn_mfma_f32_16x16x32_bf16(a, pbB, oB[dt], 0, 0, 0); }
            }
            const float rlA = 1.0f / lA, rlB = 1.0f / lB;
            bf16* opA = O + (size_t)(qrow0 + iA) * D + h * 64 + 4 * fq; bf16* opB = opA + 16 * D;
#pragma unroll
            for (int dt = 0; dt < 4; ++dt) { u32x2 w; w.x = pk2(oA[dt][0] * rlA, oA[dt][1] * rlA); w.y = pk2(oA[dt][2] * rlA, oA[dt][3] * rlA); *(u32x2*)(opA + 16 * dt) = w;
                w.x = pk2(oB[dt][0] * rlB, oB[dt][1] * rlB); w.y = pk2(oB[dt][2] * rlB, oB[dt][3] * rlB); *(u32x2*)(opB + 16 * dt) = w; }
        }
        __syncthreads();
    }
}

__device__ __forceinline__ void sample_attn(const bf16* __restrict__ Q, const bf16* __restrict__ KS, const bf16* __restrict__ VTS, const float* __restrict__ sinks, bf16* __restrict__ O, int gw, int ngw, int lane) {
    for (int item = gw; item < MS * NH; item += ngw) {
        const int r = item >> 5, h = item & 31, b = r >> 3, t = r & 7, kvh = h >> 3;
        const bf16* qp = Q + (size_t)(MP + r) * D + h * 64;
        float q[64];
#pragma unroll
        for (int c = 0; c < 8; ++c) { const u32x4 w = *(const u32x4*)(qp + 8 * c); q[8 * c] = bflo(w.x); q[8 * c + 1] = bfhi(w.x); q[8 * c + 2] = bflo(w.y); q[8 * c + 3] = bfhi(w.y); q[8 * c + 4] = bflo(w.z); q[8 * c + 5] = bfhi(w.z); q[8 * c + 6] = bflo(w.w); q[8 * c + 7] = bfhi(w.w); }
        const bf16* vp = VTS + ((size_t)(b * NKV + kvh) * HD + lane) * SVP;
        u32x4 vv[17];
#pragma unroll
        for (int c = 0; c < 17; ++c) vv[c] = *(const u32x4*)(vp + 8 * c);
        float sc[3]; float mx = sinks[h] * LOG2E; const float sink2 = mx;
#pragma unroll
        for (int k = 0; k < 3; ++k) {
            const int f = lane + 64 * k; float s = -INFINITY;
            if (f >= t + 1 && f <= t + WIN && f < SKF) {
                const bf16* kp = KS + ((size_t)b * SKF + f) * KVW + kvh * 64; s = 0.f;
#pragma unroll
                for (int c = 0; c < 8; ++c) { const u32x4 w = *(const u32x4*)(kp + 8 * c);
                    s += q[8 * c] * bflo(w.x) + q[8 * c + 1] * bfhi(w.x) + q[8 * c + 2] * bflo(w.y) + q[8 * c + 3] * bfhi(w.y) + q[8 * c + 4] * bflo(w.z) + q[8 * c + 5] * bfhi(w.z) + q[8 * c + 6] * bflo(w.w) + q[8 * c + 7] * bfhi(w.w); }
            }
            sc[k] = s; mx = fmaxf(mx, s);
        }
#pragma unroll
        for (int o = 1; o < 64; o <<= 1) mx = fmaxf(mx, shx(mx, o, lane));
        float l = 0.f;
#pragma unroll
        for (int k = 0; k < 3; ++k) { sc[k] = __builtin_amdgcn_exp2f(sc[k] - mx); l += sc[k]; }
        l = wave_sum(l, lane) + __builtin_amdgcn_exp2f(sink2 - mx);
        float o = 0.f;
#pragma unroll
        for (int c = 0; c < 17; ++c) {
            const int k = (8 * c) >> 6;
#pragma unroll
            for (int e = 0; e < 8; ++e) { const int f = 8 * c + e; const float pf = __int_as_float(__builtin_amdgcn_ds_bpermute((f & 63) << 2, __float_as_int(sc[k])));
                const unsigned w = (e < 2) ? vv[c].x : (e < 4) ? vv[c].y : (e < 6) ? vv[c].z : vv[c].w; o += pf * ((e & 1) ? bfhi(w) : bflo(w)); }
        }
        O[(size_t)(MP + r) * D + h * 64 + lane] = (bf16)pk2(o / l, 0.f);
    }
}

#define XB_TMO      128
#define XB_XCNT(j)  (256  + 64 * (j))
#define XB_XSUB(j)  (1280 + 64 * (j))
#define XB_XGEN(j)  (2304 + 64 * (j))
#define XB_TOP      3328
#define XB_TOPGEN   3392
#define XCD_BAR_WORDS 3456
#define XB_SPIN_CAP (1u << 18)

__device__ __forceinline__ unsigned xb_ld(unsigned* p)              { return __hip_atomic_load(p, __ATOMIC_RELAXED, __HIP_MEMORY_SCOPE_AGENT); }
__device__ __forceinline__ unsigned xb_add(unsigned* p, unsigned v) { return __hip_atomic_fetch_add(p, v, __ATOMIC_RELAXED, __HIP_MEMORY_SCOPE_AGENT); }
__device__ __forceinline__ unsigned xb_xcc_id() { return (unsigned)__builtin_amdgcn_s_getreg((3 << 11) | 20) & 0xFu; }
#define XB_SPIN(cond, bar) do { unsigned _sp = 0; while (cond) { __builtin_amdgcn_s_sleep(1); \
    if ((++_sp & 255u) == 0u) { if (xb_ld(&(bar)[XB_TMO])) break; if (_sp > XB_SPIN_CAP) { atomicAdd(&(bar)[XB_TMO], 1u); break; } } } } while (0)

struct XcdBarrier {
    unsigned* bar; unsigned x;
    volatile LAS unsigned* st;
};

__device__ __forceinline__ XcdBarrier xcd_barrier_post(unsigned* bar, volatile LAS unsigned* st) {
    XcdBarrier b; b.bar = bar; b.x = xb_xcc_id(); b.st = st;
    if (threadIdx.x == 0) (void)xb_add(&bar[XB_XCNT(b.x)], 1u);
    return b;
}
__device__ __forceinline__ void xcd_barrier_complete(unsigned* bar, unsigned x, unsigned& nloc, unsigned& nx) {
    const unsigned G = gridDim.x * gridDim.y * gridDim.z;
    unsigned sum, cnt, mine, sp = 0u;
    for (;;) {
        sum = 0u; cnt = 0u; mine = 0u;
#pragma unroll
        for (unsigned j = 0; j < 16; ++j) { const unsigned c = xb_ld(&bar[XB_XCNT(j)]); sum += c; cnt += (c > 0u) ? 1u : 0u; mine = (j == x) ? c : mine; }
        if (sum == G) break;
        __builtin_amdgcn_s_sleep(1);
        if ((++sp & 255u) == 0u) { if (xb_ld(&bar[XB_TMO])) break; if (sp > XB_SPIN_CAP) { atomicAdd(&bar[XB_TMO], 1u); break; } }
    }
    nloc = mine > 0u ? mine : 1u; nx = cnt > 0u ? cnt : 1u;
}

__device__ __forceinline__ void xcd_barrier(const XcdBarrier& b) {
    asm volatile("s_waitcnt vmcnt(0)" ::: "memory");
    __syncthreads();
    if (threadIdx.x == 0) {
        unsigned* bar = b.bar;
        __builtin_amdgcn_s_waitcnt(0);
        unsigned nloc = b.st[0], nx = b.st[1];
        if (nloc == 0u) { xcd_barrier_complete(bar, b.x, nloc, nx); b.st[0] = nloc; b.st[1] = nx; }
        const unsigned old = xb_add(&bar[XB_XSUB(b.x)], 1u);
        const unsigned gen = old / nloc;
        if (old + 1u == (gen + 1u) * nloc) {
            __builtin_amdgcn_fence(__ATOMIC_RELEASE, "agent");
            asm volatile("s_waitcnt vmcnt(0)" ::: "memory");
            const unsigned og = xb_add(&bar[XB_TOP], 1u);
            const unsigned tg = og / nx;
            if (og + 1u == (tg + 1u) * nx) xb_add(&bar[XB_TOPGEN], 1u);
            else XB_SPIN(xb_ld(&bar[XB_TOPGEN]) == tg, bar);
            __builtin_amdgcn_fence(__ATOMIC_ACQUIRE, "agent");
            xb_add(&bar[XB_XGEN(b.x)], 1u);
            asm volatile("s_waitcnt vmcnt(0)" ::: "memory");
        } else {
            XB_SPIN(xb_ld(&bar[XB_XGEN(b.x)]) == gen, bar);
            __builtin_amdgcn_fence(__ATOMIC_ACQUIRE, "agent");
            asm volatile("s_waitcnt vmcnt(0)" ::: "memory");
        }
    }
    __syncthreads();
}

struct Args { const float* in[17]; float* out; unsigned char* ws; int ph_lo, ph_hi; };
template <int BYTE_OFF> __device__ __forceinline__ const float* karg_ptr() {
    __attribute__((address_space(1))) const float* p; const char* ka = (const char*)__builtin_amdgcn_kernarg_segment_ptr();
    asm volatile("s_load_dwordx2 %0, %1, %2\n\ts_waitcnt lgkmcnt(0)" : "=s"(p) : "s"(ka), "n"(BYTE_OFF) : "memory");
    return (const float*)p;
}
#define ARG_IN(i) karg_ptr<8 * (i)>()

struct GemmDesc { const bf16* A; const bf16* Bt; int N, K, type, ldc; bf16* outb; const float* srcP; };

__global__ void __launch_bounds__(NTHREADS, 2) fwd_megakernel(Args a) {
    extern __shared__ __attribute__((aligned(16))) unsigned char lds_raw[];
    cg::grid_group grid = cg::this_grid();
    LAS unsigned char* lds = (LAS unsigned char*)lds_raw;
    const int G = gridDim.x, ngw = G * NWAVES, nthreads = G * NTHREADS;
    if (threadIdx.x < 16) ((LAS unsigned*)(lds + LDS_RING))[threadIdx.x] = 0u;
    __syncthreads();
    (void)xcd_barrier_post((unsigned*)((unsigned char*)karg_ptr<144>() + WS_BAR), (volatile LAS unsigned*)(lds + LDS_RING));
#ifndef DBG_PH
#define DBG_PH 15
#endif
#pragma unroll 1
    for (int ph = a.ph_lo; ph <= a.ph_hi; ++ph) {
        int tid_ = threadIdx.x; asm volatile("" : "+v"(tid_));
        const int tid = tid_, lane = tid & 63, wave = __builtin_amdgcn_readfirstlane(tid >> 6);
        const int gw = blockIdx.x * NWAVES + wave, gtid = blockIdx.x * NTHREADS + tid;
        unsigned char* ws = (unsigned char*)karg_ptr<144>(); float* out = (float*)karg_ptr<136>();
    bf16* const WT[8] = {(bf16*)(ws + WS_WIN), (bf16*)(ws + WS_WOUT), (bf16*)(ws + WS_WQKV), (bf16*)(ws + WS_WATT), (bf16*)(ws + WS_WUP0), (bf16*)(ws + WS_WUP1), (bf16*)(ws + WS_WDN0), (bf16*)(ws + WS_WDN1)};
    bf16* const H0 = (bf16*)(ws + WS_H); bf16* const H1 = (bf16*)(ws + WS_HX); bf16* const H2 = (bf16*)(ws + WS_HX + 33 * MiB); bf16* const H3 = (bf16*)(ws + WS_HX + 66 * MiB); bf16* const BCV = (bf16*)(ws + WS_BCV); bf16* const GB = (bf16*)(ws + WS_G); bf16* const AB = (bf16*)(ws + WS_A);
    bf16* const QKV = (bf16*)(ws + WS_QKV); bf16* const QB = (bf16*)(ws + WS_Q); bf16* const OB = (bf16*)(ws + WS_O);
    bf16* const KP = (bf16*)(ws + WS_KP); bf16* const VTP = (bf16*)(ws + WS_VTP); bf16* const KS = (bf16*)(ws + WS_KS); bf16* const VTS = (bf16*)(ws + WS_VTS);

        const bool tails = G >= 128;
#define CONVERT_ITEMS(LO, HI, FIRST, STRIDE) { LAS unsigned* T = (LAS unsigned*)(lds + wave * (64 * 33 * 4)); \
            for (int it = (LO) + (FIRST); it < (HI); it += (STRIDE)) { \
                int r = it; const float* W; const float* gain = nullptr; bf16* dst; int K = D, N; \
                if (r < 3072) { W = ARG_IN(7); gain = ARG_IN(5); dst = WT[0]; N = NIN; } \
                else if ((r -= 3072) < 1024) { W = ARG_IN(9); dst = WT[1]; N = D; } \
                else if ((r -= 1024) < 1280) { W = ARG_IN(10); gain = ARG_IN(5) + D; dst = WT[2]; N = NQKV; } \
                else if ((r -= 1280) < 1024) { W = ARG_IN(11); dst = WT[3]; N = D; } \
                else if ((r -= 1024) < 4096) { W = ARG_IN(15); gain = ARG_IN(6); dst = WT[4]; N = FF; } \
                else if ((r -= 4096) < 4096) { W = ARG_IN(15) + (size_t)D * FF; gain = ARG_IN(6) + D; dst = WT[5]; N = FF; } \
                else if ((r -= 4096) < 4096) { W = ARG_IN(16); dst = WT[6]; K = FF; N = D; } \
                else { r -= 4096; W = ARG_IN(16) + (size_t)D * FF; dst = WT[7]; K = FF; N = D; } \
                transpose_item(W, gain, dst, K, N, r, T, lane); } }
#ifdef DBG_EMPTY_FROM
        if (ph >= DBG_EMPTY_FROM) {   } else
#endif
        if (ph == 0) {
            if (tails) { CONVERT_ITEMS(0, 3072, gw, ngw) } else { CONVERT_ITEMS(0, 22784, gw, ngw) }
            rms_rows(ARG_IN(0), ARG_IN(1), H0, out + (size_t)MP * D, nullptr, 0, gw, ngw, lane);
        } else if (ph == 2) {
            conv_phase(BCV, ARG_IN(2), ARG_IN(8), GB, out + O_CP, out + O_CS, gtid, nthreads);
        } else if (ph == 4 || ph == 7 || ph == 12) {
            rms_rows(out, out + (size_t)MP * D, ph == 4 ? H1 : (ph == 7 ? H2 : H3), out + (size_t)MP * D, (const float*)(ws + WS_PART), ph == 7 ? 16 : 8, gw, ngw, lane);
        } else if (ph == 15) {
            reduce_sample(out + (size_t)MP * D, (const float*)(ws + WS_PART), 16, gw, ngw, lane);
        } else if (ph == 9) {
            PostArgs P{QKV, ARG_IN(12), ARG_IN(13), ARG_IN(3), ARG_IN(4), QB, KP, VTP, KS, VTS, out};
            post_phase(P, gw, ngw, lane, gtid, nthreads, tails ? 1 : 3);
        } else if (ph == 10) {
            attn_phase(lds, QB, KP, VTP, KS, VTS, ARG_IN(14), OB, G);
            sample_attn(QB, KS, VTS, ARG_IN(14), OB, gw, ngw, lane);
        } else {
#define RUN_BF16(ACT, ID, Aptr, Bptr, NN, KK, OUT) { const pg8::Gemm gg{Aptr, Bptr, M, NN, KK}; pg8::StaticOrderT<M, NN, KK> S; S.G = G; S.c = (int)blockIdx.x; const pg8::EpiBf16<ACT, ID> E{OUT, NN}; \
                pg8::gemm_phase<pg8::EpiBf16<ACT, ID>, pg8::StaticOrderT<M, NN, KK>, true, true>(lds, gg, S, E); }
#define RUN_RES(ID, Aptr, Bptr, KK, NS, SRCP) { const pg8::Gemm gg{Aptr, Bptr, M, D, KK}; pg8::SplitOrderT<KK, NS> S; S.G = G; S.c = (int)blockIdx.x; const pg8::EpiRes<ID> E{SRCP, out, (float*)(ws + WS_PART)}; \
                pg8::gemm_phase<pg8::EpiRes<ID>, pg8::SplitOrderT<KK, NS>, true, true>(lds, gg, S, E); }
            if (ph == 1) RUN_BF16(0, 1, H0, WT[0], NIN, D, BCV)
            else if (ph == 3) RUN_RES(3, GB, WT[1], D, 8, ARG_IN(0))
            else if (ph == 5) RUN_BF16(1, 5, H1, WT[4], FF, D, AB)
            else if (ph == 6) RUN_RES(6, AB, WT[6], FF, 16, nullptr)
            else if (ph == 8) RUN_BF16(0, 8, H2, WT[2], NQKV, D, QKV)
            else if (ph == 11) RUN_RES(11, OB, WT[3], D, 8, nullptr)
            else if (ph == 13) RUN_BF16(1, 13, H3, WT[5], FF, D, AB)
            else RUN_RES(14, AB, WT[7], FF, 16, nullptr)
#undef RUN_BF16
#undef RUN_RES
            if (tails && ph == 1 && blockIdx.x >= 24) { const int hw = ((int)blockIdx.x - 24) * NWAVES + wave, nhw = (G - 24) * NWAVES;
                CONVERT_ITEMS(3072, 4096, hw, nhw) CONVERT_ITEMS(6400, 10496, hw, nhw) CONVERT_ITEMS(14592, 18688, hw, nhw) }
            if (tails && ph == 8 && blockIdx.x >= 74) {
                PostArgs P{QKV, ARG_IN(12), ARG_IN(13), ARG_IN(3), ARG_IN(4), QB, KP, VTP, KS, VTS, out};
                post_phase(P, 0, 1, lane, ((int)blockIdx.x - 74) * NTHREADS + tid, (G - 74) * NTHREADS, 2); }
            if (tails && ph == 5 && blockIdx.x >= 32) { const int hw = ((int)blockIdx.x - 32) * NWAVES + wave, nhw = (G - 32) * NWAVES;
                CONVERT_ITEMS(4096, 6400, hw, nhw) CONVERT_ITEMS(10496, 14592, hw, nhw) CONVERT_ITEMS(18688, 22784, hw, nhw) }
        }
        if (a.ph_lo == 0 && (ph != a.ph_hi || DBG_PH != 15)) {
            XcdBarrier xb; xb.bar = (unsigned*)(ws + WS_BAR); xb.x = xb_xcc_id(); xb.st = (volatile LAS unsigned*)(lds + LDS_RING);
            xcd_barrier(xb);
        } else
        if (ph != a.ph_hi || DBG_PH != 15) {
            asm volatile("s_waitcnt vmcnt(0)" ::: "memory");
            __syncthreads();
            if (threadIdx.x == 0) { __builtin_amdgcn_fence(__ATOMIC_RELEASE, "agent"); asm volatile("s_waitcnt vmcnt(0)" ::: "memory"); }
            grid.sync();
            if (threadIdx.x == 0) { __builtin_amdgcn_fence(__ATOMIC_ACQUIRE, "agent"); asm volatile("s_waitcnt vmcnt(0)" ::: "memory"); }
            __syncthreads();
        }
    }
#if DBG_PH != 15
    {
        const int gtid = blockIdx.x * NTHREADS + threadIdx.x; unsigned char* ws = (unsigned char*)karg_ptr<144>(); float* out = (float*)karg_ptr<136>();
        const unsigned* w0 = (const unsigned*)(ws); const unsigned* w1 = (const unsigned*)(ws + WS_H); const unsigned* w2 = (const unsigned*)(ws + WS_R);
        unsigned x0 = 0, x1 = 0, x2 = 0;
        for (size_t i = gtid; i < (178 * MiB) / 4; i += nthreads) x0 ^= w0[i];
        for (size_t i = gtid; i < (33 * MiB) / 4; i += nthreads) x1 ^= w1[i];
        for (size_t i = gtid; i < (174 * MiB) / 4; i += nthreads) x2 ^= w2[i];
        out[O_KS + gtid] = (float)((x0 ^ (x0 >> 12)) & 0xfffffu); out[O_KS + nthreads + gtid] = (float)((x1 ^ (x1 >> 12)) & 0xfffffu); out[O_KS + 2 * nthreads + gtid] = (float)((x2 ^ (x2 >> 12)) & 0xfffffu);
    }
#endif
}

extern "C" void kernel_launch(void* const* d_in, const int* in_sizes, int n_in, void* d_out, int out_size, void* d_ws, size_t ws_size, hipStream_t stream) {
    static int grid_blocks = 0;
    if (grid_blocks == 0) {
        if (n_in != 17 || ws_size < WS_END) { fprintf(stderr, "kernel_launch: unexpected inputs (n_in %d, ws %zu)\n", n_in, ws_size); grid_blocks = -1; return; }
        int dev = 0, cus = 0, per_cu = 0;
        if (hipGetDevice(&dev) != hipSuccess || hipDeviceGetAttribute(&cus, hipDeviceAttributeMultiprocessorCount, dev) != hipSuccess) { grid_blocks = -1; return; }
        if (hipFuncSetAttribute((const void*)fwd_megakernel, hipFuncAttributeMaxDynamicSharedMemorySize, LDS_BYTES) != hipSuccess) { fprintf(stderr, "kernel_launch: hipFuncSetAttribute failed\n"); grid_blocks = -1; return; }
        if (hipOccupancyMaxActiveBlocksPerMultiprocessor(&per_cu, (const void*)fwd_megakernel, NTHREADS, LDS_BYTES) != hipSuccess || per_cu < 1) { fprintf(stderr, "kernel_launch: occupancy query reports %d blocks per CU\n", per_cu); grid_blocks = -1; return; }
        grid_blocks = cus;
    }
    if (grid_blocks < 0) return;
    Args a{};
    for (int i = 0; i < 17; ++i) a.in[i] = (const float*)d_in[i];
    a.out = (float*)d_out; a.ws = (unsigned char*)d_ws;
#ifndef MK_LAUNCHES
#define MK_LAUNCHES 1
#endif
    if (hipMemsetAsync((char*)d_ws + WS_BAR, 0, 16384, stream) != hipSuccess) { fprintf(stderr, "kernel_launch: hipMemsetAsync of the barrier words failed\n"); return; }
    void* args[] = {&a};
    if (MK_LAUNCHES == 1) {
        a.ph_lo = 0; a.ph_hi = DBG_PH;
        hipError_t e = hipLaunchCooperativeKernel((const void*)fwd_megakernel, dim3(grid_blocks), dim3(NTHREADS), args, LDS_BYTES, stream);
        if (e != hipSuccess) fprintf(stderr, "cooperative launch failed: %s (grid %d)\n", hipGetErrorString(e), grid_blocks);
    } else {
        for (int ph = 0; ph <= DBG_PH; ++ph) {
            a.ph_lo = ph; a.ph_hi = ph;
            hipError_t e = hipLaunchCooperativeKernel((const void*)fwd_megakernel, dim3(grid_blocks), dim3(NTHREADS), args, LDS_BYTES, stream);
            if (e != hipSuccess) { fprintf(stderr, "launch %d failed: %s\n", ph, hipGetErrorString(e)); break; }
        }
    }
}
```

```cpp
#include <hip/hip_runtime.h>
#include <hip/hip_cooperative_groups.h>
#include <cstdio>
#include <cstdint>
namespace cg = cooperative_groups;
namespace pg8 {
#define PG8_LAS __attribute__((address_space(3)))
typedef unsigned short bf16_t;
typedef short bf16x8 __attribute__((ext_vector_type(8)));
typedef float f32x4 __attribute__((ext_vector_type(4)));
typedef unsigned u32x4 __attribute__((ext_vector_type(4)));
constexpr int BM = 256, BK = 64, HALF = 128, HTB = HALF * BK * 2  , STAGE_BYTES = 8 * HTB, NXCD = 8, WGM = 8;

__host__ __device__ __forceinline__ int lds_byte(int r, int c) { const int st = (r >> 4) * 2 + (c >> 5), rr = r & 15, cc = c & 31, ob = rr * 64 + cc * 2; return st * 1024 + (ob ^ (((ob >> 9) & 1) << 5)); }
__host__ __device__ __forceinline__ void stage_rc(int b, int& R, int& C) { const int st = b / 1024, sb = b % 1024, swz = sb ^ (((sb >> 9) & 1) << 5); R = (st >> 1) * 16 + swz / 64; C = (st & 1) * 32 + (swz % 64) / 2; }
__host__ __device__ __forceinline__ int perm32(int rho) { const int n = rho >> 4, i = rho & 15; return 8 * (i >> 2) + 4 * n + (i & 3); }

struct Unit { int pm, pn, nt, split; };
struct Gemm { const bf16_t* A; const bf16_t* Bt; int M, N, K; };

template <int M_, int N_, int K_> struct StaticOrderT {
    static constexpr int KDIM = K_, nM = M_ / BM, nN = N_ / BM, nwg = nM * nN, ntk = K_ / BK;
    int G, c;
    __device__ __forceinline__ bool next(int i, Unit& u) const { const long L = (long)i * G + c; if (L >= nwg) return false; map((int)L, u); return true; }
    static __device__ __forceinline__ void map(int L, Unit& u) {
        u.nt = ntk; u.split = 0;
        int wgid = L; { constexpr int q = nwg / NXCD, r = nwg % NXCD; const int xcd = wgid % NXCD, off = wgid / NXCD; wgid = (xcd < r ? xcd * (q + 1) : r * (q + 1) + (xcd - r) * q) + off; }
        constexpr int nig = WGM * nN; const int gid = wgid / nig, fm = gid * WGM, gsz = (nM - fm) < WGM ? (nM - fm) : WGM;
        u.pm = fm + ((wgid % nig) % gsz); u.pn = (wgid % nig) / gsz;
    }
    __device__ __forceinline__ void a_ready(const Unit&) const {}
    __device__ __forceinline__ void done(const Unit&) const {}
};
template <int K_, int NS> struct SplitOrderT {
    typedef StaticOrderT<8192, 2048, K_> Base;
    static constexpr int KDIM = K_, ntS = K_ / BK / NS;
    int G, c;
    __device__ __forceinline__ bool next(int i, Unit& u) const {
        const int L = i * G + c; const bool isb = L < Base::nwg; const int j = L - Base::nwg;
        Unit b; Base::map(isb ? L : 0, b);
        u.pm = isb ? b.pm : Base::nM; u.pn = isb ? b.pn : (j % Base::nN); u.split = isb ? 0 : (j / Base::nN); u.nt = isb ? Base::ntk : ntS;
        return isb || j < Base::nN * NS;
    }
    __device__ __forceinline__ void a_ready(const Unit&) const {}
    __device__ __forceinline__ void done(const Unit&) const {}
};

__device__ __forceinline__ unsigned cvt_pk_bf16(float lo, float hi) { unsigned r; asm volatile("v_cvt_pk_bf16_f32 %0, %1, %2" : "=v"(r) : "v"(lo), "v"(hi)); return r; }
template <int ACT  , int ID = 0  > struct EpiBf16 {
    static constexpr bool PERM = true, AFTER_DRAIN = false;
    bf16_t* O; int ldc;
    __device__ __forceinline__ void operator()(const f32x4 (&acc)[2][2][4][2], const Unit& u, int wr, int wc, int fr, int fq) const {
        asm volatile("" : "+v"(fr), "+v"(fq));
        const int row0 = u.pm * BM + wr * 64 + fr; const int col0 = u.pn * BM + wc * 32 + 8 * fq;
#pragma unroll
        for (int ai = 0; ai < 2; ++ai)
#pragma unroll
            for (int m = 0; m < 4; ++m) { bf16_t* rowp = O + (size_t)(row0 + ai * HALF + m * 16) * ldc + col0;
#pragma unroll
                for (int bj = 0; bj < 2; ++bj) { f32x4 v0 = acc[ai][bj][m][0], v1 = acc[ai][bj][m][1];
                    if (ACT == 1) {
#pragma unroll
                        for (int e = 0; e < 4; ++e) { const float a = fmaxf(v0[e], 0.f), b = fmaxf(v1[e], 0.f); v0[e] = a * a; v1[e] = b * b; } }
                    u32x4 w; w.x = cvt_pk_bf16(v0[0], v0[1]); w.y = cvt_pk_bf16(v0[2], v0[3]); w.z = cvt_pk_bf16(v1[0], v1[1]); w.w = cvt_pk_bf16(v1[2], v1[3]);
                    *(u32x4*)(rowp + bj * HALF) = w; } }
    }
};
template <int ID = 0> struct EpiRes {
    static constexpr bool PERM = false, AFTER_DRAIN = false;
    const float* srcP; float* dst; float* part;
    __device__ __forceinline__ void operator()(const f32x4 (&acc)[2][2][4][2], const Unit& u, int wr, int wc, int fr, int fq) const {
        asm volatile("" : "+v"(fr), "+v"(fq));
        const bool sp = u.pm >= 32;
        float* wb = (sp ? part + (size_t)u.split * (BM * 2048) : dst + (size_t)u.pm * (BM * 2048)) + (u.pn * BM + wc * 32 + 4 * fq);
        const float* sb = (srcP != nullptr && !sp) ? srcP + (size_t)u.pm * (BM * 2048) + (u.pn * BM + wc * 32 + 4 * fq) : wb;
#pragma unroll
        for (int ai = 0; ai < 2; ++ai)
#pragma unroll
            for (int m = 0; m < 4; ++m) { const int off = (ai * HALF + wr * 64 + m * 16 + fr) * 2048;
                f32x4 v[2][2];
#pragma unroll
                for (int bj = 0; bj < 2; ++bj)
#pragma unroll
                    for (int n = 0; n < 2; ++n) v[bj][n] = (f32x4){0.f, 0.f, 0.f, 0.f};
                if (!sp) {
#pragma unroll
                    for (int bj = 0; bj < 2; ++bj)
#pragma unroll
                        for (int n = 0; n < 2; ++n) v[bj][n] = *(const f32x4*)(sb + off + bj * HALF + n * 16);
                }
#pragma unroll
                for (int bj = 0; bj < 2; ++bj)
#pragma unroll
                    for (int n = 0; n < 2; ++n) *(f32x4*)(wb + off + bj * HALF + n * 16) = v[bj][n] + acc[ai][bj][m][n];
                asm volatile("" ::: "memory"); }
    }
};

template <class Epi, class Sched, bool ALIGN_EPI = false, bool SP2 = false>
__device__ __forceinline__ void gemm_phase(PG8_LAS unsigned char* lds, const Gemm g, const Sched& S, const Epi& E) {
    int tid_ = threadIdx.x; asm volatile("" : "+v"(tid_)); const int tid = tid_, wid = __builtin_amdgcn_readfirstlane(tid >> 6), lane = tid & 63, wr = wid >> 2, wc = wid & 3, fr = lane & 15, fq = lane >> 4;
    constexpr int K = Sched::KDIM;
    unsigned voffA[2], voffB[2];
#pragma unroll
    for (int i = 0; i < 2; ++i) { int R, C; stage_rc(tid * 16 + i * 8192, R, C); const int Rb = Epi::PERM ? ((R & ~31) + perm32(R & 31)) : R;
        voffA[i] = (unsigned)(R * K + C) * 2u; voffB[i] = (unsigned)(Rb * K + C) * 2u; }
    const size_t kstep = (size_t)(BK * 2);
    const size_t hstep = (size_t)HALF * K * 2;
    const size_t tstep = 2 * hstep;
    const unsigned ldsw = (unsigned)wid * 1024u;
    const int aoff = lds_byte(wr * 64 + fr, fq * 8), boff = lds_byte(wc * 32 + fr, fq * 8);
#define PG8_SA(b, h) (((b) * 2 + (h)) * HTB)
#define PG8_SB(b, h) ((4 + (b) * 2 + (h)) * HTB)
#define PG8_STAGE(bufoff, gbase, voff) do { _Pragma("unroll") for (int _i = 0; _i < 2; ++_i) \
        __builtin_amdgcn_global_load_lds((const unsigned*)((const char*)(gbase) + (voff)[_i]), (PG8_LAS unsigned*)(lds + (bufoff) + ldsw + _i * 8192), 16, 0, 0); } while (0)
#define PG8_LDA(dst, b, h) do { _Pragma("unroll") for (int m = 0; m < 4; ++m) _Pragma("unroll") for (int k = 0; k < 2; ++k) dst[m][k] = *(const PG8_LAS bf16x8*)(lds + PG8_SA(b, h) + aoff + m * 2048 + k * 1024); } while (0)
#define PG8_LDB(dst, b, h) do { _Pragma("unroll") for (int n = 0; n < 2; ++n) _Pragma("unroll") for (int k = 0; k < 2; ++k) dst[n][k] = *(const PG8_LAS bf16x8*)(lds + PG8_SB(b, h) + boff + n * 2048 + k * 1024); } while (0)
#define PG8_MMA(ai, bj, At, Bt) do { __builtin_amdgcn_s_setprio(1); _Pragma("unroll") for (int m = 0; m < 4; ++m) _Pragma("unroll") for (int n = 0; n < 2; ++n) _Pragma("unroll") for (int k = 0; k < 2; ++k) \
        acc[ai][bj][m][n] = __builtin_amdgcn_mfma_f32_16x16x32_bf16(Bt[n][k], At[m][k], acc[ai][bj][m][n], 0, 0, 0); __builtin_amdgcn_s_setprio(0); } while (0)
#define PG8_WAIT_V(n) asm volatile("s_waitcnt vmcnt(" #n ")" ::: "memory")
#define PG8_WAIT_L(n) asm volatile("s_waitcnt lgkmcnt(" #n ")" ::: "memory")
#define PG8_BAR __builtin_amdgcn_s_barrier()
#define PG8_SCHED __builtin_amdgcn_sched_barrier(0)
    Unit cur, nxt; int ui = 0;
    if (!S.next(0, cur)) return;
    f32x4 acc[2][2][4][2];
#pragma unroll
    for (int a = 0; a < 2; ++a)
#pragma unroll
        for (int b = 0; b < 2; ++b)
#pragma unroll
            for (int m = 0; m < 4; ++m)
#pragma unroll
                for (int n = 0; n < 2; ++n) acc[a][b][m][n] = (f32x4){0.f, 0.f, 0.f, 0.f};
    bf16x8 At[4][2], B0[2][2], B1[2][2];
    const char* cA = (const char*)g.A + (size_t)cur.pm * tstep + (size_t)(cur.split * cur.nt) * kstep; const char* cB = (const char*)g.Bt + (size_t)cur.pn * tstep + (size_t)(cur.split * cur.nt) * kstep;
    S.a_ready(cur);
    if constexpr (SP2) {
        PG8_STAGE(PG8_SB(0, 0), cB, voffB); PG8_STAGE(PG8_SB(0, 1), cB + hstep, voffB); PG8_STAGE(PG8_SA(0, 0), cA, voffA); PG8_STAGE(PG8_SA(0, 1), cA + hstep, voffA);
        if (wr == 1) PG8_BAR;
        PG8_WAIT_V(2); PG8_BAR;
        PG8_STAGE(PG8_SB(1, 0), cB + kstep, voffB); PG8_STAGE(PG8_SA(1, 0), cA + kstep, voffA); PG8_STAGE(PG8_SB(1, 1), cB + hstep + kstep, voffB);
        PG8_WAIT_V(6); PG8_BAR;
    } else {
        PG8_STAGE(PG8_SB(0, 0), cB, voffB); PG8_STAGE(PG8_SA(0, 0), cA, voffA); PG8_STAGE(PG8_SB(0, 1), cB + hstep, voffB); PG8_STAGE(PG8_SA(0, 1), cA + hstep, voffA);
        if (wr == 1) PG8_BAR;
        PG8_WAIT_V(4); PG8_BAR;
        PG8_STAGE(PG8_SB(1, 0), cB + kstep, voffB); PG8_STAGE(PG8_SA(1, 0), cA + kstep, voffA); PG8_STAGE(PG8_SB(1, 1), cB + hstep + kstep, voffB);
        PG8_WAIT_V(6); PG8_BAR;
    }
    for (;;) {
        const bool has_next = S.next(ui + 1, nxt);
        const char* nA = has_next ? (const char*)g.A + (size_t)nxt.pm * tstep + (size_t)(nxt.split * nxt.nt) * kstep : cA; const char* nB = has_next ? (const char*)g.Bt + (size_t)nxt.pn * tstep + (size_t)(nxt.split * nxt.nt) * kstep : cB;
        const int nt = cur.nt;
        for (int t = 0; t < nt; t += 2) {
            const bool last = (t == nt - 2);
            const char* a1 = cA + (size_t)(t + 1) * kstep;
            const char* a2 = last ? nA : cA + (size_t)(t + 2) * kstep; const char* b2 = last ? nB : cB + (size_t)(t + 2) * kstep;
            const char* a3 = a2 + kstep; const char* b3 = b2 + kstep;
            if (last && has_next) S.a_ready(nxt);
            if constexpr (SP2) {
            PG8_LDB(B0, 0, 0); PG8_LDB(B1, 0, 1); PG8_SCHED; PG8_LDA(At, 0, 0); PG8_STAGE(PG8_SA(1, 1), a1 + hstep, voffA);
            PG8_WAIT_V(8); PG8_WAIT_L(0); PG8_BAR; PG8_MMA(0, 0, At, B0); PG8_MMA(0, 1, At, B1); PG8_BAR; PG8_SCHED;
            PG8_LDA(At, 0, 1); PG8_STAGE(PG8_SB(0, 0), b2, voffB); PG8_STAGE(PG8_SB(0, 1), b2 + hstep, voffB); PG8_STAGE(PG8_SA(0, 0), a2, voffA);
            PG8_WAIT_V(8); PG8_WAIT_L(0); PG8_BAR; PG8_MMA(1, 0, At, B0); PG8_MMA(1, 1, At, B1); PG8_BAR; PG8_SCHED;
            PG8_LDB(B0, 1, 0); PG8_LDB(B1, 1, 1); PG8_SCHED; PG8_LDA(At, 1, 0); PG8_STAGE(PG8_SA(0, 1), a2 + hstep, voffA);
            PG8_WAIT_V(8); PG8_WAIT_L(0); PG8_BAR; PG8_MMA(0, 0, At, B0); PG8_MMA(0, 1, At, B1); PG8_BAR; PG8_SCHED;
            PG8_LDA(At, 1, 1); PG8_STAGE(PG8_SB(1, 0), b3, voffB); PG8_STAGE(PG8_SB(1, 1), b3 + hstep, voffB); PG8_STAGE(PG8_SA(1, 0), a3, voffA);
            PG8_WAIT_V(8); PG8_WAIT_L(0); PG8_BAR; PG8_MMA(1, 0, At, B0); PG8_MMA(1, 1, At, B1); PG8_BAR; PG8_SCHED;
            } else {
            PG8_LDB(B0, 0, 0); PG8_SCHED; PG8_LDA(At, 0, 0); PG8_STAGE(PG8_SA(1, 1), a1 + hstep, voffA);
            PG8_WAIT_L(8); PG8_BAR; PG8_WAIT_L(0); PG8_MMA(0, 0, At, B0); PG8_BAR; PG8_SCHED;
            PG8_LDB(B1, 0, 1); PG8_STAGE(PG8_SB(0, 0), b2, voffB);
            PG8_BAR; PG8_WAIT_L(0); PG8_MMA(0, 1, At, B1); PG8_BAR;
            PG8_LDA(At, 0, 1); PG8_STAGE(PG8_SA(0, 0), a2, voffA);
            PG8_BAR; PG8_WAIT_L(0); PG8_MMA(1, 0, At, B0); PG8_BAR; PG8_SCHED;
            PG8_STAGE(PG8_SB(0, 1), b2 + hstep, voffB);
            PG8_WAIT_V(6); PG8_BAR; PG8_MMA(1, 1, At, B1); PG8_BAR;
            PG8_LDB(B0, 1, 0); PG8_SCHED; PG8_LDA(At, 1, 0); PG8_STAGE(PG8_SA(0, 1), a2 + hstep, voffA);
            PG8_WAIT_L(8); PG8_BAR; PG8_WAIT_L(0); PG8_MMA(0, 0, At, B0); PG8_BAR; PG8_SCHED;
            PG8_LDB(B1, 1, 1); PG8_STAGE(PG8_SB(1, 0), b3, voffB);
            PG8_BAR; PG8_WAIT_L(0); PG8_MMA(0, 1, At, B1); PG8_BAR;
            PG8_LDA(At, 1, 1); PG8_STAGE(PG8_SA(1, 0), a3, voffA);
            PG8_BAR; PG8_WAIT_L(0); PG8_MMA(1, 0, At, B0); PG8_BAR; PG8_SCHED;
            PG8_STAGE(PG8_SB(1, 1), b3 + hstep, voffB);
            PG8_WAIT_V(6); PG8_BAR; PG8_MMA(1, 1, At, B1); PG8_BAR;
            }
        }
        if constexpr (ALIGN_EPI) { if (wr == 0) PG8_BAR; }
        if constexpr (!Epi::AFTER_DRAIN) { E(acc, cur, wr, wc, fr, fq); S.done(cur); }
        if (!has_next) break;
#pragma unroll
        for (int a = 0; a < 2; ++a)
#pragma unroll
            for (int b = 0; b < 2; ++b)
#pragma unroll
                for (int m = 0; m < 4; ++m)
#pragma unroll
                    for (int n = 0; n < 2; ++n) acc[a][b][m][n] = (f32x4){0.f, 0.f, 0.f, 0.f};
        cur = nxt; cA = nA; cB = nB; ++ui;
        if constexpr (ALIGN_EPI) { if (wr == 1) PG8_BAR; }
    }
    PG8_WAIT_V(0);
    if constexpr (!ALIGN_EPI) { if (wr == 0) PG8_BAR; }
    PG8_BAR;
    if constexpr (Epi::AFTER_DRAIN) { E.fused(acc, cur, wr, wc, fr, fq, lds, wid, lane); S.done(cur); }
#undef PG8_SA
#undef PG8_SB
#undef PG8_STAGE
#undef PG8_LDA
#undef PG8_LDB
#undef PG8_MMA
#undef PG8_WAIT_V
#undef PG8_WAIT_L
#undef PG8_BAR
#undef PG8_SCHED
}
}
constexpr int D = 2048, SEQ = 4096, NBATCH = 2, MP = NBATCH * SEQ, DEC_B = 32, DEC_T = 8, MS = DEC_B * DEC_T, M = MP + MS;
constexpr int FF = 8192, NIN = 3 * D, HD = 64, NH = 32, NKV = 4, KVW = NKV * HD, NQKV = NH * HD + 2 * KVW, PAST = 16384, WIN = 128;
constexpr int SKF = WIN + DEC_T;
constexpr int SVP = 144;
constexpr float EPS = 1e-6f, LOG2E = 1.4426950408889634f, QSCALE = 0.125f * LOG2E;
constexpr size_t O_CP = (size_t)M * D, O_CS = O_CP + (size_t)NBATCH * 2 * D, O_KP = O_CS + (size_t)DEC_B * 2 * D, O_VP = O_KP + (size_t)NBATCH * WIN * KVW,
                 O_KS = O_VP + (size_t)NBATCH * WIN * KVW, O_VS = O_KS + (size_t)DEC_B * WIN * KVW;
constexpr size_t MiB = 1u << 20;
constexpr size_t WS_WIN = 0, WS_WOUT = 24 * MiB, WS_WQKV = 32 * MiB, WS_WATT = 42 * MiB, WS_WUP0 = 50 * MiB, WS_WUP1 = 82 * MiB, WS_WDN0 = 114 * MiB, WS_WDN1 = 146 * MiB;
constexpr size_t WS_H = 180 * MiB, WS_R = 214 * MiB, WS_A = WS_R, WS_BCV = WS_R, WS_G = WS_R + 99 * MiB, WS_QKV = WS_R + 132 * MiB  , WS_Q = WS_R + 42 * MiB, WS_O = WS_R + 75 * MiB;
constexpr size_t WS_KP = WS_R + 108 * MiB, WS_VTP = WS_R + 112 * MiB, WS_KS = WS_R + 116 * MiB, WS_VTS = WS_R + 119 * MiB, WS_HX = WS_R + 174 * MiB  , WS_END = WS_HX + 99 * MiB;
static_assert((size_t)8448 * 6144 * 2 <= 99 * MiB && (size_t)8448 * 8192 * 2 <= 132 * MiB && (size_t)8448 * 2560 * 2 <= 42 * MiB && (size_t)8448 * 2048 * 2 <= 33 * MiB, "ws map");
constexpr size_t WS_PART = WS_QKV;
constexpr size_t WS_BAR = 178 * MiB;
constexpr int LDS_RING = 131072, LDS_BYTES = LDS_RING + 64;
constexpr int NTHREADS = 512, NWAVES = 8;

#define LAS __attribute__((address_space(3)))
typedef unsigned short bf16;
typedef float f32x4 __attribute__((ext_vector_type(4)));
typedef unsigned u32x4 __attribute__((ext_vector_type(4)));
typedef unsigned u32x2 __attribute__((ext_vector_type(2)));
typedef short bf16x8 __attribute__((ext_vector_type(8)));
__device__ __forceinline__ float bf2f(unsigned v) { return __uint_as_float(v << 16); }
__device__ __forceinline__ float bflo(unsigned w) { return __uint_as_float(w << 16); }
__device__ __forceinline__ float bfhi(unsigned w) { return __uint_as_float(w & 0xffff0000u); }
__device__ __forceinline__ unsigned pk2(float lo, float hi) { return pg8::cvt_pk_bf16(lo, hi); }
__device__ __forceinline__ float shx(float v, int o, int lane) { return __int_as_float(__builtin_amdgcn_ds_bpermute((lane ^ o) << 2, __float_as_int(v))); }
__device__ __forceinline__ float wave_sum(float v, int lane) {
#pragma unroll
    for (int o = 1; o < 64; o <<= 1) v += shx(v, o, lane);
    return v;
}
__device__ const double ROPE_INV[32] = {1.0, 0.7498942093324559, 0.5623413251903491, 0.4216965034285822, 0.31622776601683794, 0.23713737056616552, 0.1778279410038923, 0.1333521432163324,
    0.1, 0.07498942093324558, 0.05623413251903491, 0.042169650342858224, 0.03162277660168379, 0.023713737056616554, 0.01778279410038923, 0.01333521432163324,
    0.01, 0.007498942093324558, 0.005623413251903491, 0.004216965034285823, 0.0031622776601683794, 0.0023713737056616554, 0.0017782794100389228, 0.001333521432163324,
    0.001, 0.0007498942093324559, 0.0005623413251903491, 0.00042169650342858224, 0.00031622776601683794, 0.00023713737056616554, 0.00017782794100389227, 0.0001333521432163324};

__device__ __forceinline__ void transpose_item(const float* __restrict__ W, const float* __restrict__ gain, bf16* __restrict__ WT, int K, int N, int item, LAS unsigned* T, int lane) {
    const int nblk = N >> 6, kb = item / nblk, nb = item - kb * nblk, k0 = kb * 64, n0 = nb * 64;
    const int j = lane & 15, g = lane >> 4;
    const float* src = W + (size_t)(k0 + 2 * g) * N + n0 + 4 * j;
    f32x4 a[8], b[8];
#pragma unroll
    for (int i = 0; i < 8; ++i) { a[i] = *(const f32x4*)(src + (size_t)(8 * i) * N); b[i] = *(const f32x4*)(src + (size_t)(8 * i + 1) * N); }
    if (gain != nullptr) {
#pragma unroll
        for (int i = 0; i < 8; ++i) { const float ga = gain[k0 + 8 * i + 2 * g], gb = gain[k0 + 8 * i + 2 * g + 1]; a[i] = a[i] * ga; b[i] = b[i] * gb; }
    }
#pragma unroll
    for (int i = 0; i < 8; ++i) {
        const int r = 4 * i + g;
#pragma unroll
        for (int e = 0; e < 4; ++e) T[(4 * j + e) * 33 + r] = pk2(a[i][e], b[i][e]);
    }
    asm volatile("s_waitcnt lgkmcnt(0)" ::: "memory");
    const int c = lane & 7;
#pragma unroll
    for (int q = 0; q < 8; ++q) {
        const int n = (lane >> 3) + 8 * q; const LAS unsigned* s = T + n * 33 + 4 * c;
        u32x4 o; o.x = s[0]; o.y = s[1]; o.z = s[2]; o.w = s[3];
        *(u32x4*)(WT + (size_t)(n0 + n) * K + k0 + 8 * c) = o;
    }
    asm volatile("s_waitcnt lgkmcnt(0)" ::: "memory");
}

__device__ __forceinline__ void rms_load(f32x4 (&v)[8], const float* xr, int lane) {
#pragma unroll
    for (int j = 0; j < 4; ++j) { v[2 * j] = *(const f32x4*)(xr + j * 512 + lane * 8); v[2 * j + 1] = *(const f32x4*)(xr + j * 512 + lane * 8 + 4); }
}
__device__ __forceinline__ void rms_finish(const f32x4 (&v)[8], bf16* __restrict__ hr, int lane) {
    float ss = 0.f;
#pragma unroll
    for (int j = 0; j < 8; ++j) ss += (v[j][0] * v[j][0] + v[j][1] * v[j][1]) + (v[j][2] * v[j][2] + v[j][3] * v[j][3]);
    ss = wave_sum(ss, lane);
    const float rstd = 1.0f / sqrtf(ss * (1.0f / D) + EPS);
#pragma unroll
    for (int j = 0; j < 4; ++j) { const f32x4 p = v[2 * j] * rstd, q = v[2 * j + 1] * rstd; u32x4 o; o.x = pk2(p[0], p[1]); o.y = pk2(p[2], p[3]); o.z = pk2(q[0], q[1]); o.w = pk2(q[2], q[3]);
        *(u32x4*)(hr + j * 512 + lane * 8) = o; }
}
__device__ __forceinline__ void rms_rows(const float* srcP, const float* srcS, bf16* __restrict__ H, float* copyS, const float* part, int nsplit, LAS float* red, int gw, int ngw, int lane) {
    const int wave = gw & (NWAVES - 1), blk = gw >> 3, nblk = ngw >> 3;
    for (int sr = blk; sr < MS; sr += nblk) {
        const int c = wave * 256 + lane * 4;
        f32x4 v = *(const f32x4*)(srcS + (size_t)sr * D + c);
        if (part != nullptr) { const float* pr = part + (size_t)sr * D + c; f32x4 p[16];
#pragma unroll
            for (int s = 0; s < 16; ++s) p[s] = (s < nsplit) ? *(const f32x4*)(pr + (size_t)s * MS * D) : (f32x4){0.f, 0.f, 0.f, 0.f};
#pragma unroll
            for (int s = 0; s < 16; ++s) v += p[s]; }
        float ss = (v[0] * v[0] + v[1] * v[1]) + (v[2] * v[2] + v[3] * v[3]);
        ss = wave_sum(ss, lane);
        if (lane == 0) red[wave] = ss;
        __syncthreads();
        float tot = 0.f;
#pragma unroll
        for (int w = 0; w < NWAVES; ++w) tot += red[w];
        __syncthreads();
        const float rstd = 1.0f / sqrtf(tot * (1.0f / D) + EPS);
        if (copyS != nullptr) *(f32x4*)(copyS + (size_t)sr * D + c) = v;
        u32x2 o; o.x = pk2(v[0] * rstd, v[1] * rstd); o.y = pk2(v[2] * rstd, v[3] * rstd);
        *(u32x2*)(H + (size_t)(MP + sr) * D + c) = o;
    }
    for (int row = gw; row < MP; row += 2 * ngw) {
        const int row2 = row + ngw; const bool two = row2 < MP;
        f32x4 a[8], b[8];
        rms_load(a, srcP + (size_t)row * D, lane);
        if (two) rms_load(b, srcP + (size_t)row2 * D, lane);
        rms_finish(a, H + (size_t)row * D, lane);
        if (two) rms_finish(b, H + (size_t)row2 * D, lane);
    }
}

__device__ __forceinline__ void reduce_sample(float* __restrict__ yS, const float* __restrict__ part, int nsplit, int gw, int ngw, int lane) {
    const int wave = gw & (NWAVES - 1), blk = gw >> 3, nblk = ngw >> 3;
    for (int sr = blk; sr < MS; sr += nblk) {
        const int c = wave * 256 + lane * 4; float* yr = yS + (size_t)sr * D + c;
        f32x4 v = *(const f32x4*)yr; const float* pr = part + (size_t)sr * D + c; f32x4 p[16];
#pragma unroll
        for (int s = 0; s < 16; ++s) p[s] = (s < nsplit) ? *(const f32x4*)(pr + (size_t)s * MS * D) : (f32x4){0.f, 0.f, 0.f, 0.f};
#pragma unroll
        for (int s = 0; s < 16; ++s) v += p[s];
        *(f32x4*)yr = v;
    }
}

__device__ __forceinline__ void unpack8(const u32x4 w, float (&f)[8]) { f[0] = bflo(w.x); f[1] = bfhi(w.x); f[2] = bflo(w.y); f[3] = bfhi(w.y); f[4] = bflo(w.z); f[5] = bfhi(w.z); f[6] = bflo(w.w); f[7] = bfhi(w.w); }
__device__ __forceinline__ void conv_phase(const bf16* __restrict__ bcv, const float* __restrict__ state, const float* __restrict__ wconv, bf16* __restrict__ G, float* __restrict__ out_cp, float* __restrict__ out_cs, int gtid, int nthreads) {
    for (int item = gtid; item < (M / 8) * 256; item += nthreads) {
        const int rb = item >> 8, dc = item & 255, d0 = dc * 8, r0 = rb * 8;
        float w0[8], w1[8], w2[8], up2[8], up1[8];
        { const f32x4 a = *(const f32x4*)(wconv + d0), b = *(const f32x4*)(wconv + d0 + 4), c = *(const f32x4*)(wconv + D + d0), d = *(const f32x4*)(wconv + D + d0 + 4), e = *(const f32x4*)(wconv + 2 * D + d0), f = *(const f32x4*)(wconv + 2 * D + d0 + 4);
#pragma unroll
          for (int k = 0; k < 4; ++k) { w0[k] = a[k]; w0[4 + k] = b[k]; w1[k] = c[k]; w1[4 + k] = d[k]; w2[k] = e[k]; w2[4 + k] = f[k]; } }
        const bool samp = r0 >= MP; const int sb = (r0 - MP) >> 3;
        if (samp) {
            const f32x4 a = *(const f32x4*)(state + (size_t)(sb * 2) * D + d0), b = *(const f32x4*)(state + (size_t)(sb * 2) * D + d0 + 4), c = *(const f32x4*)(state + (size_t)(sb * 2 + 1) * D + d0), d = *(const f32x4*)(state + (size_t)(sb * 2 + 1) * D + d0 + 4);
#pragma unroll
            for (int k = 0; k < 4; ++k) { up2[k] = a[k]; up2[4 + k] = b[k]; up1[k] = c[k]; up1[4 + k] = d[k]; }
        } else if ((r0 & (SEQ - 1)) == 0) {
#pragma unroll
            for (int k = 0; k < 8; ++k) { up2[k] = 0.f; up1[k] = 0.f; }
        } else {
            float c[8], v[8];
            unpack8(*(const u32x4*)(bcv + (size_t)(r0 - 2) * NIN + D + d0), c); unpack8(*(const u32x4*)(bcv + (size_t)(r0 - 2) * NIN + 2 * D + d0), v);
#pragma unroll
            for (int k = 0; k < 8; ++k) up2[k] = c[k] * v[k];
            unpack8(*(const u32x4*)(bcv + (size_t)(r0 - 1) * NIN + D + d0), c); unpack8(*(const u32x4*)(bcv + (size_t)(r0 - 1) * NIN + 2 * D + d0), v);
#pragma unroll
            for (int k = 0; k < 8; ++k) up1[k] = c[k] * v[k];
        }
#pragma unroll
        for (int rr = 0; rr < 8; ++rr) {
            const bf16* rp = bcv + (size_t)(r0 + rr) * NIN + d0;
            float bg[8], c[8], v[8], u[8], g[8];
            unpack8(*(const u32x4*)rp, bg); unpack8(*(const u32x4*)(rp + D), c); unpack8(*(const u32x4*)(rp + 2 * D), v);
#pragma unroll
            for (int k = 0; k < 8; ++k) { u[k] = c[k] * v[k]; g[k] = bg[k] * (w0[k] * up2[k] + w1[k] * up1[k] + w2[k] * u[k]); up2[k] = up1[k]; up1[k] = u[k]; }
            u32x4 o; o.x = pk2(g[0], g[1]); o.y = pk2(g[2], g[3]); o.z = pk2(g[4], g[5]); o.w = pk2(g[6], g[7]);
            *(u32x4*)(G + (size_t)(r0 + rr) * D + d0) = o;
        }
        float* op = nullptr;
        if (samp) op = out_cs + (size_t)(sb * 2) * D + d0;
        else if ((r0 & (SEQ - 1)) == SEQ - 8) op = out_cp + (size_t)((r0 >> 12) * 2) * D + d0;
        if (op != nullptr) {
            *(f32x4*)op = (f32x4){up2[0], up2[1], up2[2], up2[3]}; *(f32x4*)(op + 4) = (f32x4){up2[4], up2[5], up2[6], up2[7]};
            *(f32x4*)(op + D) = (f32x4){up1[0], up1[1], up1[2], up1[3]}; *(f32x4*)(op + D + 4) = (f32x4){up1[4], up1[5], up1[6], up1[7]};
        }
    }
}

struct PostArgs { const bf16* raw; const float* qn; const float* kn; const float* cache_k; const float* cache_v; bf16* Q; bf16* KP; bf16* VTP; bf16* KS; bf16* VTS; float* out; };
__device__ __forceinline__ void post_phase(const PostArgs& P, int gw, int ngw, int lane, int gtid, int nthreads, int parts  ) {
    if (parts & 1) {
        const int l8 = lane & 7, l4 = lane & 3; const bool first = l8 < 4;
        double inv[8]; float gq[8], gk[8];
#pragma unroll
        for (int e = 0; e < 8; ++e) { inv[e] = ROPE_INV[8 * l4 + e] * 0.15915494309189535; gq[e] = P.qn[8 * l8 + e]; gk[e] = P.kn[8 * l8 + e]; }
        for (int row = gw; row < M; row += ngw) {
            const bool samp = row >= MP; int b, t, pos;
            if (!samp) { b = row >> 12; t = row & (SEQ - 1); pos = t; } else { b = (row - MP) >> 3; t = (row - MP) & 7; pos = PAST + t; }
            const bf16* src = P.raw + (size_t)row * NQKV + 8 * lane;
            u32x4 ch[5];
#pragma unroll
            for (int j = 0; j < 5; ++j) ch[j] = *(const u32x4*)(src + 512 * j);
            float cs[8], sn[8];
#pragma unroll
            for (int e = 0; e < 8; ++e) { const double rev = (double)pos * inv[e]; const float fr = (float)(rev - __builtin_rint(rev)); sn[e] = __builtin_amdgcn_sinf(fr); cs[e] = __builtin_amdgcn_cosf(fr); }
#pragma unroll
            for (int j = 0; j < 5; ++j) {
                float x[8], o[8]; unpack8(ch[j], x);
                float ss = 0.f;
#pragma unroll
                for (int e = 0; e < 8; ++e) ss += x[e] * x[e];
                ss += shx(ss, 1, lane); ss += shx(ss, 2, lane); ss += shx(ss, 4, lane);
                const float rstd = 1.0f / sqrtf(ss * (1.0f / HD) + EPS);
#pragma unroll
                for (int e = 0; e < 8; ++e) { const float y = x[e] * rstd * (j < 4 ? gq[e] : gk[e]); const float py = shx(y, 4, lane); o[e] = first ? y * cs[e] - py * sn[e] : y * cs[e] + py * sn[e]; }
                if (j < 4) {
                    u32x4 w; w.x = pk2(o[0] * QSCALE, o[1] * QSCALE); w.y = pk2(o[2] * QSCALE, o[3] * QSCALE); w.z = pk2(o[4] * QSCALE, o[5] * QSCALE); w.w = pk2(o[6] * QSCALE, o[7] * QSCALE);
                    *(u32x4*)(P.Q + (size_t)row * D + 512 * j + 8 * lane) = w;
                } else if (lane < 32) {
                    u32x4 w; w.x = pk2(o[0], o[1]); w.y = pk2(o[2], o[3]); w.z = pk2(o[4], o[5]); w.w = pk2(o[6], o[7]);
                    float* op = nullptr;
                    if (!samp) { *(u32x4*)(P.KP + (size_t)row * KVW + 8 * lane) = w; if (t >= SEQ - WIN) op = P.out + O_KP + (size_t)(b * WIN + (t - (SEQ - WIN))) * KVW + 8 * lane; }
                    else { *(u32x4*)(P.KS + ((size_t)b * SKF + WIN + t) * KVW + 8 * lane) = w; op = P.out + O_KS + (size_t)(b * WIN + (WIN - DEC_T) + t) * KVW + 8 * lane; }
                    if (op != nullptr) { *(f32x4*)op = (f32x4){o[0], o[1], o[2], o[3]}; *(f32x4*)(op + 4) = (f32x4){o[4], o[5], o[6], o[7]}; }
                }
            }
        }
    }
    for (int item = (parts & 1) ? gw : M; item < M / 8; item += ngw) {
        const int r0 = item * 8; const int c4 = 4 * lane, kvh = c4 >> 6, d = c4 & 63;
        float v[8][4];
#pragma unroll
        for (int rr = 0; rr < 8; ++rr) { const u32x2 w = *(const u32x2*)(P.raw + (size_t)(r0 + rr) * NQKV + NH * HD + KVW + c4); v[rr][0] = bflo(w.x); v[rr][1] = bfhi(w.x); v[rr][2] = bflo(w.y); v[rr][3] = bfhi(w.y); }
        if (r0 < MP) {
            const int b = r0 >> 12, t0 = r0 & (SEQ - 1);
#pragma unroll
            for (int e = 0; e < 4; ++e) { u32x4 o; o.x = pk2(v[0][e], v[1][e]); o.y = pk2(v[2][e], v[3][e]); o.z = pk2(v[4][e], v[5][e]); o.w = pk2(v[6][e], v[7][e]);
                *(u32x4*)(P.VTP + ((size_t)(b * NKV + kvh) * HD + d + e) * SEQ + t0) = o; }
            if (t0 >= SEQ - WIN) {
#pragma unroll
                for (int rr = 0; rr < 8; ++rr) *(f32x4*)(P.out + O_VP + (size_t)(b * WIN + (t0 + rr - (SEQ - WIN))) * KVW + c4) = (f32x4){v[rr][0], v[rr][1], v[rr][2], v[rr][3]};
            }
        } else {
            const int b = (r0 - MP) >> 3;
#pragma unroll
            for (int e = 0; e < 4; ++e) { u32x4 o; o.x = pk2(v[0][e], v[1][e]); o.y = pk2(v[2][e], v[3][e]); o.z = pk2(v[4][e], v[5][e]); o.w = pk2(v[6][e], v[7][e]);
                bf16* vp = P.VTS + ((size_t)(b * NKV + kvh) * HD + d + e) * SVP; *(u32x4*)(vp + WIN) = o; *(u32x4*)(vp + WIN + 8) = (u32x4){0u, 0u, 0u, 0u}; }
#pragma unroll
            for (int rr = 0; rr < 8; ++rr) *(f32x4*)(P.out + O_VS + (size_t)(b * WIN + (WIN - DEC_T) + rr) * KVW + c4) = (f32x4){v[rr][0], v[rr][1], v[rr][2], v[rr][3]};
        }
    }
    for (int idx = (parts & 2) ? gtid : DEC_B * WIN * (KVW / 4); idx < DEC_B * WIN * (KVW / 4); idx += nthreads) {
        const int f = idx & (WIN - 1), c4 = ((idx >> 7) & 63) * 4, b = idx >> 13, kvh = c4 >> 6, d = c4 & 63;
        const f32x4 kc = *(const f32x4*)(P.cache_k + ((size_t)b * WIN + f) * KVW + c4), vc = *(const f32x4*)(P.cache_v + ((size_t)b * WIN + f) * KVW + c4);
        u32x2 kk; kk.x = pk2(kc[0], kc[1]); kk.y = pk2(kc[2], kc[3]);
        *(u32x2*)(P.KS + ((size_t)b * SKF + f) * KVW + c4) = kk;
#pragma unroll
        for (int e = 0; e < 4; ++e) P.VTS[((size_t)(b * NKV + kvh) * HD + d + e) * SVP + f] = (bf16)pk2(vc[e], 0.f);
        if (f >= DEC_T) { *(f32x4*)(P.out + O_KS + ((size_t)b * WIN + f - DEC_T) * KVW + c4) = kc; *(f32x4*)(P.out + O_VS + ((size_t)b * WIN + f - DEC_T) * KVW + c4) = vc; }
    }
}

constexpr int KROW = 144, VROW = 528, ATT_K_BYTES = 256 * KROW;
__device__ __forceinline__ void attn_phase(LAS unsigned char* lds, const bf16* __restrict__ Q, const bf16* __restrict__ KP, const bf16* __restrict__ VTP, const bf16* __restrict__ KS, const bf16* __restrict__ VTS,
                                           const float* __restrict__ sinks, bf16* __restrict__ O, int G) {
    int tid_ = threadIdx.x; asm volatile("" : "+v"(tid_)); const int tid = tid_, lane = tid & 63, wid = __builtin_amdgcn_readfirstlane(tid >> 6), fr = lane & 15, fq = lane >> 4;
    LAS unsigned char* Ksm = lds; LAS unsigned char* Vsm = lds + ATT_K_BYTES;
    for (int u = blockIdx.x; u < 256; u += G) {
        int nq, qrow0, f0, nk, nkv, kvh, vpitch; const bf16* kbase; const bf16* vbase;
        if (u < 256) { const int b = u >> 7, n = u & 31; kvh = (u >> 5) & 3; nq = 128; qrow0 = b * SEQ + n * 128; f0 = (n == 0) ? 128 : 0; nk = 256; nkv = 256;
            kbase = KP + ((long)(b * SEQ) + (long)(n - 1) * 128) * KVW + kvh * 64; vbase = VTP + (long)((b * NKV + kvh) * HD) * SEQ + (long)(n - 1) * 128; vpitch = SEQ; }
        else { const int s = u - 256, b = s >> 2; kvh = s & 3; nq = DEC_T; qrow0 = MP + b * DEC_T; f0 = 0; nk = SKF; nkv = SVP;
            kbase = KS + (long)b * SKF * KVW + kvh * 64; vbase = VTS + (long)((b * NKV + kvh) * HD) * SVP; vpitch = SVP; }
#pragma unroll
        for (int i = 0; i < 4; ++i) { const int id = tid + NTHREADS * i, f = id >> 3, c = id & 7; u32x4 v = (u32x4){0u, 0u, 0u, 0u};
            if (f >= f0 && f < nk) v = *(const u32x4*)(kbase + (long)f * KVW + c * 8);
            *(LAS u32x4*)(Ksm + f * KROW + c * 16) = v; }
#pragma unroll
        for (int i = 0; i < 4; ++i) { const int id = tid + NTHREADS * i, d = id >> 5, c = id & 31; u32x4 v = (u32x4){0u, 0u, 0u, 0u};
            if (8 * c >= f0 && 8 * c < nkv) v = *(const u32x4*)(vbase + (long)d * vpitch + 8 * c);
            *(LAS u32x4*)(Vsm + d * VROW + c * 16) = v; }
        __syncthreads();
        const int h = kvh * 8 + wid; const float sink2 = sinks[h] * LOG2E;
        const int nsub = (nq + 15) >> 4;
        for (int sp = 0; sp < 4; ++sp) {
            const int iA = 32 * sp + fr, iB = iA + 16, ktb = 2 * sp;
            const bf16* qpA = Q + (size_t)(qrow0 + iA) * D + h * 64 + 8 * fq; const bf16* qpB = qpA + 16 * D;
            const bf16x8 qA0 = *(const bf16x8*)qpA, qA1 = *(const bf16x8*)(qpA + 32), qB0 = *(const bf16x8*)qpB, qB1 = *(const bf16x8*)(qpB + 32);
            f32x4 sA[10], sB[10];
#pragma unroll
            for (int j = 0; j < 10; ++j) { const LAS unsigned char* kr = Ksm + (16 * (ktb + j) + fr) * KROW + fq * 16;
                const bf16x8 a0 = *(const LAS bf16x8*)kr, a1 = *(const LAS bf16x8*)(kr + 64);
                f32x4 accA = (f32x4){0.f, 0.f, 0.f, 0.f}, accB = accA;
                accA = __builtin_amdgcn_mfma_f32_16x16x32_bf16(a0, qA0, accA, 0, 0, 0); accB = __builtin_amdgcn_mfma_f32_16x16x32_bf16(a0, qB0, accB, 0, 0, 0);
                accA = __builtin_amdgcn_mfma_f32_16x16x32_bf16(a1, qA1, accA, 0, 0, 0); accB = __builtin_amdgcn_mfma_f32_16x16x32_bf16(a1, qB1, accB, 0, 0, 0); sA[j] = accA; sB[j] = accB; }
            float mxA = -INFINITY, mxB = -INFINITY;
#pragma unroll
            for (int j = 0; j < 10; ++j)
#pragma unroll
                for (int e = 0; e < 4; ++e) { const int f = 16 * (ktb + j) + 4 * fq + e;
                    const bool okA = (f >= iA + 1) && (f <= iA + WIN) && (f >= f0), okB = (f >= iB + 1) && (f <= iB + WIN) && (f >= f0);
                    sA[j][e] = okA ? sA[j][e] : -INFINITY; mxA = fmaxf(mxA, sA[j][e]); sB[j][e] = okB ? sB[j][e] : -INFINITY; mxB = fmaxf(mxB, sB[j][e]); }
            mxA = fmaxf(mxA, shx(mxA, 16, lane)); mxB = fmaxf(mxB, shx(mxB, 16, lane)); mxA = fmaxf(mxA, shx(mxA, 32, lane)); mxB = fmaxf(mxB, shx(mxB, 32, lane));
            mxA = fmaxf(mxA, sink2); mxB = fmaxf(mxB, sink2);
            float lA = 0.f, lB = 0.f;
#pragma unroll
            for (int j = 0; j < 10; ++j)
#pragma unroll
                for (int e = 0; e < 4; ++e) { const float pA = __builtin_amdgcn_exp2f(sA[j][e] - mxA), pB = __builtin_amdgcn_exp2f(sB[j][e] - mxB); sA[j][e] = pA; lA += pA; sB[j][e] = pB; lB += pB; }
            lA += shx(lA, 16, lane); lB += shx(lB, 16, lane); lA += shx(lA, 32, lane); lB += shx(lB, 32, lane);
            lA += __builtin_amdgcn_exp2f(sink2 - mxA); lB += __builtin_amdgcn_exp2f(sink2 - mxB);
            f32x4 oA[4], oB[4];
#pragma unroll
            for (int dt = 0; dt < 4; ++dt) { oA[dt] = (f32x4){0.f, 0.f, 0.f, 0.f}; oB[dt] = oA[dt]; }
#pragma unroll
            for (int jp = 0; jp < 5; ++jp) {
                u32x4 pw; pw.x = pk2(sA[2 * jp][0], sA[2 * jp][1]); pw.y = pk2(sA[2 * jp][2], sA[2 * jp][3]); pw.z = pk2(sA[2 * jp + 1][0], sA[2 * jp + 1][1]); pw.w = pk2(sA[2 * jp + 1][2], sA[2 * jp + 1][3]);
                const bf16x8 pbA = __builtin_bit_cast(bf16x8, pw);
                pw.x = pk2(sB[2 * jp][0], sB[2 * jp][1]); pw.y = pk2(sB[2 * jp][2], sB[2 * jp][3]); pw.z = pk2(sB[2 * jp + 1][0], sB[2 * jp + 1][1]); pw.w = pk2(sB[2 * jp + 1][2], sB[2 * jp + 1][3]);
                const bf16x8 pbB = __builtin_bit_cast(bf16x8, pw);
#pragma unroll
                for (int dt = 0; dt < 4; ++dt) { const LAS unsigned char* vr = Vsm + (16 * dt + fr) * VROW + (16 * (ktb + 2 * jp) + 4 * fq) * 2;
                    const u32x2 lo = *(const LAS u32x2*)vr, hi = *(const LAS u32x2*)(vr + 32);
                    const bf16x8 a = __builtin_bit_cast(bf16x8, (u32x4){lo.x, lo.y, hi.x, hi.y});
                    oA[dt] = __builtin_amdgcn_mfma_f32_16x16x32_bf16(a, pbA, oA[dt], 0, 0, 0); oB[dt] = __builtin_amdgcn_mfma_f32_16x16x32_bf16(a, pbB, oB[dt], 0, 0, 0); }
            }
            const float rlA = 1.0f / lA, rlB = 1.0f / lB;
            bf16* opA = O + (size_t)(qrow0 + iA) * D + h * 64 + 4 * fq; bf16* opB = opA + 16 * D;
#pragma unroll
            for (int dt = 0; dt < 4; ++dt) { u32x2 w; w.x = pk2(oA[dt][0] * rlA, oA[dt][1] * rlA); w.y = pk2(oA[dt][2] * rlA, oA[dt][3] * rlA); *(u32x2*)(opA + 16 * dt) = w;
                w.x = pk2(oB[dt][0] * rlB, oB[dt][1] * rlB); w.y = pk2(oB[dt][2] * rlB, oB[dt][3] * rlB); *(u32x2*)(opB + 16 * dt) = w; }
        }
        __syncthreads();
    }
}

__device__ __forceinline__ void sample_attn(const bf16* __restrict__ Q, const bf16* __restrict__ KS, const bf16* __restrict__ VTS, const float* __restrict__ sinks, bf16* __restrict__ O, int gw, int ngw, int lane) {
    for (int item = gw; item < MS * NH; item += ngw) {
        const int r = item >> 5, h = item & 31, b = r >> 3, t = r & 7, kvh = h >> 3;
        const bf16* qp = Q + (size_t)(MP + r) * D + h * 64;
        float q[64];
#pragma unroll
        for (int c = 0; c < 8; ++c) { const u32x4 w = *(const u32x4*)(qp + 8 * c); q[8 * c] = bflo(w.x); q[8 * c + 1] = bfhi(w.x); q[8 * c + 2] = bflo(w.y); q[8 * c + 3] = bfhi(w.y); q[8 * c + 4] = bflo(w.z); q[8 * c + 5] = bfhi(w.z); q[8 * c + 6] = bflo(w.w); q[8 * c + 7] = bfhi(w.w); }
        const bf16* vp = VTS + ((size_t)(b * NKV + kvh) * HD + lane) * SVP;
        u32x4 vv[17];
#pragma unroll
        for (int c = 0; c < 17; ++c) vv[c] = *(const u32x4*)(vp + 8 * c);
        float sc[3]; float mx = sinks[h] * LOG2E; const float sink2 = mx;
#pragma unroll
        for (int k = 0; k < 3; ++k) {
            const int f = lane + 64 * k; float s = -INFINITY;
            if (f >= t + 1 && f <= t + WIN && f < SKF) {
                const bf16* kp = KS + ((size_t)b * SKF + f) * KVW + kvh * 64; s = 0.f;
#pragma unroll
                for (int c = 0; c < 8; ++c) { const u32x4 w = *(const u32x4*)(kp + 8 * c);
                    s += q[8 * c] * bflo(w.x) + q[8 * c + 1] * bfhi(w.x) + q[8 * c + 2] * bflo(w.y) + q[8 * c + 3] * bfhi(w.y) + q[8 * c + 4] * bflo(w.z) + q[8 * c + 5] * bfhi(w.z) + q[8 * c + 6] * bflo(w.w) + q[8 * c + 7] * bfhi(w.w); }
            }
            sc[k] = s; mx = fmaxf(mx, s);
        }
#pragma unroll
        for (int o = 1; o < 64; o <<= 1) mx = fmaxf(mx, shx(mx, o, lane));
        float l = 0.f;
#pragma unroll
        for (int k = 0; k < 3; ++k) { sc[k] = __builtin_amdgcn_exp2f(sc[k] - mx); l += sc[k]; }
        l = wave_sum(l, lane) + __builtin_amdgcn_exp2f(sink2 - mx);
        float o = 0.f;
#pragma unroll
        for (int c = 0; c < 17; ++c) {
            const int k = (8 * c) >> 6;
#pragma unroll
            for (int e = 0; e < 8; ++e) { const int f = 8 * c + e; const float pf = __int_as_float(__builtin_amdgcn_ds_bpermute((f & 63) << 2, __float_as_int(sc[k])));
                const unsigned w = (e < 2) ? vv[c].x : (e < 4) ? vv[c].y : (e < 6) ? vv[c].z : vv[c].w; o += pf * ((e & 1) ? bfhi(w) : bflo(w)); }
        }
        O[(size_t)(MP + r) * D + h * 64 + lane] = (bf16)pk2(o / l, 0.f);
    }
}

#define XB_TMO      128
#define XB_XCNT(j)  (256  + 64 * (j))
#define XB_XSUB(j)  (1280 + 64 * (j))
#define XB_XGEN(j)  (2304 + 64 * (j))
#define XB_TOP      3328
#define XB_TOPGEN   3392
#define XCD_BAR_WORDS 3456
#define XB_SPIN_CAP (1u << 18)

__device__ __forceinline__ unsigned xb_ld(unsigned* p)              { return __hip_atomic_load(p, __ATOMIC_RELAXED, __HIP_MEMORY_SCOPE_AGENT); }
__device__ __forceinline__ unsigned xb_add(unsigned* p, unsigned v) { return __hip_atomic_fetch_add(p, v, __ATOMIC_RELAXED, __HIP_MEMORY_SCOPE_AGENT); }
__device__ __forceinline__ unsigned xb_xcc_id() { return (unsigned)__builtin_amdgcn_s_getreg((3 << 11) | 20) & 0xFu; }
#define XB_SPIN(cond, bar) do { unsigned _sp = 0; while (cond) { __builtin_amdgcn_s_sleep(1); \
    if ((++_sp & 255u) == 0u) { if (xb_ld(&(bar)[XB_TMO])) break; if (_sp > XB_SPIN_CAP) { atomicAdd(&(bar)[XB_TMO], 1u); break; } } } } while (0)

struct XcdBarrier {
    unsigned* bar; unsigned x;
    volatile LAS unsigned* st;
};

__device__ __forceinline__ XcdBarrier xcd_barrier_post(unsigned* bar, volatile LAS unsigned* st) {
    XcdBarrier b; b.bar = bar; b.x = xb_xcc_id(); b.st = st;
    if (threadIdx.x == 0) (void)xb_add(&bar[XB_XCNT(b.x)], 1u);
    return b;
}
__device__ __forceinline__ void xcd_barrier_complete(unsigned* bar, unsigned x, unsigned& nloc, unsigned& nx) {
    const unsigned G = gridDim.x * gridDim.y * gridDim.z;
    unsigned sum, cnt, mine, sp = 0u;
    for (;;) {
        sum = 0u; cnt = 0u; mine = 0u;
#pragma unroll
        for (unsigned j = 0; j < 16; ++j) { const unsigned c = xb_ld(&bar[XB_XCNT(j)]); sum += c; cnt += (c > 0u) ? 1u : 0u; mine = (j == x) ? c : mine; }
        if (sum == G) break;
        __builtin_amdgcn_s_sleep(1);
        if ((++sp & 255u) == 0u) { if (xb_ld(&bar[XB_TMO])) break; if (sp > XB_SPIN_CAP) { atomicAdd(&bar[XB_TMO], 1u); break; } }
    }
    nloc = mine > 0u ? mine : 1u; nx = cnt > 0u ? cnt : 1u;
}

__device__ __forceinline__ void xcd_barrier(const XcdBarrier& b) {
    asm volatile("s_waitcnt vmcnt(0)" ::: "memory");
    __syncthreads();
    if (threadIdx.x == 0) {
        unsigned* bar = b.bar;
        __builtin_amdgcn_s_waitcnt(0);
        unsigned nloc = b.st[0], nx = b.st[1];
        if (nloc == 0u) { xcd_barrier_complete(bar, b.x, nloc, nx); b.st[0] = nloc; b.st[1] = nx; }
        const unsigned old = xb_add(&bar[XB_XSUB(b.x)], 1u);
        const unsigned gen = old / nloc;
        if (old + 1u == (gen + 1u) * nloc) {
            __builtin_amdgcn_fence(__ATOMIC_RELEASE, "agent");
            asm volatile("s_waitcnt vmcnt(0)" ::: "memory");
            const unsigned og = xb_add(&bar[XB_TOP], 1u);
            const unsigned tg = og / nx;
            if (og + 1u == (tg + 1u) * nx) xb_add(&bar[XB_TOPGEN], 1u);
            else XB_SPIN(xb_ld(&bar[XB_TOPGEN]) == tg, bar);
            __builtin_amdgcn_fence(__ATOMIC_ACQUIRE, "agent");
            xb_add(&bar[XB_XGEN(b.x)], 1u);
            asm volatile("s_waitcnt vmcnt(0)" ::: "memory");
        } else {
            XB_SPIN(xb_ld(&bar[XB_XGEN(b.x)]) == gen, bar);
            __builtin_amdgcn_fence(__ATOMIC_ACQUIRE, "agent");
            asm volatile("s_waitcnt vmcnt(0)" ::: "memory");
        }
    }
    __syncthreads();
}

struct Args { const float* in[17]; float* out; unsigned char* ws; int ph_lo, ph_hi; };
template <int BYTE_OFF> __device__ __forceinline__ const float* karg_ptr() {
    __attribute__((address_space(1))) const float* p; const char* ka = (const char*)__builtin_amdgcn_kernarg_segment_ptr();
    asm volatile("s_load_dwordx2 %0, %1, %2\n\ts_waitcnt lgkmcnt(0)" : "=s"(p) : "s"(ka), "n"(BYTE_OFF) : "memory");
    return (const float*)p;
}
#define ARG_IN(i) karg_ptr<8 * (i)>()

struct GemmDesc { const bf16* A; const bf16* Bt; int N, K, type, ldc; bf16* outb; const float* srcP; };

__global__ void __launch_bounds__(NTHREADS, 2) fwd_megakernel(Args a) {
    extern __shared__ __attribute__((aligned(16))) unsigned char lds_raw[];
    cg::grid_group grid = cg::this_grid();
    LAS unsigned char* lds = (LAS unsigned char*)lds_raw;
    const int G = gridDim.x, ngw = G * NWAVES, nthreads = G * NTHREADS;
    if (threadIdx.x < 16) ((LAS unsigned*)(lds + LDS_RING))[threadIdx.x] = 0u;
    __syncthreads();
    (void)xcd_barrier_post((unsigned*)((unsigned char*)karg_ptr<144>() + WS_BAR), (volatile LAS unsigned*)(lds + LDS_RING));
#ifndef DBG_PH
#define DBG_PH 15
#endif
#pragma unroll 1
    for (int ph = a.ph_lo; ph <= a.ph_hi; ++ph) {
        int tid_ = threadIdx.x; asm volatile("" : "+v"(tid_));
        const int tid = tid_, lane = tid & 63, wave = __builtin_amdgcn_readfirstlane(tid >> 6);
        const int gw = blockIdx.x * NWAVES + wave, gtid = blockIdx.x * NTHREADS + tid;
        unsigned char* ws = (unsigned char*)karg_ptr<144>(); float* out = (float*)karg_ptr<136>();
    bf16* const WT[8] = {(bf16*)(ws + WS_WIN), (bf16*)(ws + WS_WOUT), (bf16*)(ws + WS_WQKV), (bf16*)(ws + WS_WATT), (bf16*)(ws + WS_WUP0), (bf16*)(ws + WS_WUP1), (bf16*)(ws + WS_WDN0), (bf16*)(ws + WS_WDN1)};
    bf16* const H0 = (bf16*)(ws + WS_H); bf16* const H1 = (bf16*)(ws + WS_HX); bf16* const H2 = (bf16*)(ws + WS_HX + 33 * MiB); bf16* const H3 = (bf16*)(ws + WS_HX + 66 * MiB); bf16* const BCV = (bf16*)(ws + WS_BCV); bf16* const GB = (bf16*)(ws + WS_G); bf16* const AB = (bf16*)(ws + WS_A);
    bf16* const QKV = (bf16*)(ws + WS_QKV); bf16* const QB = (bf16*)(ws + WS_Q); bf16* const OB = (bf16*)(ws + WS_O);
    bf16* const KP = (bf16*)(ws + WS_KP); bf16* const VTP = (bf16*)(ws + WS_VTP); bf16* const KS = (bf16*)(ws + WS_KS); bf16* const VTS = (bf16*)(ws + WS_VTS);

        const bool tails = G >= 128;
#define CONVERT_ITEMS(LO, HI, FIRST, STRIDE) { LAS unsigned* T = (LAS unsigned*)(lds + wave * (64 * 33 * 4)); \
            for (int it = (LO) + (FIRST); it < (HI); it += (STRIDE)) { \
                int r = it; const float* W; const float* gain = nullptr; bf16* dst; int K = D, N; \
                if (r < 3072) { W = ARG_IN(7); gain = ARG_IN(5); dst = WT[0]; N = NIN; } \
                else if ((r -= 3072) < 1024) { W = ARG_IN(9); dst = WT[1]; N = D; } \
                else if ((r -= 1024) < 1280) { W = ARG_IN(10); gain = ARG_IN(5) + D; dst = WT[2]; N = NQKV; } \
                else if ((r -= 1280) < 1024) { W = ARG_IN(11); dst = WT[3]; N = D; } \
                else if ((r -= 1024) < 4096) { W = ARG_IN(15); gain = ARG_IN(6); dst = WT[4]; N = FF; } \
                else if ((r -= 4096) < 4096) { W = ARG_IN(15) + (size_t)D * FF; gain = ARG_IN(6) + D; dst = WT[5]; N = FF; } \
                else if ((r -= 4096) < 4096) { W = ARG_IN(16); dst = WT[6]; K = FF; N = D; } \
                else { r -= 4096; W = ARG_IN(16) + (size_t)D * FF; dst = WT[7]; K = FF; N = D; } \
                transpose_item(W, gain, dst, K, N, r, T, lane); } }
#ifdef DBG_EMPTY_FROM
        if (ph >= DBG_EMPTY_FROM) {   } else
#endif
        if (ph == 0) {
            if (tails) { CONVERT_ITEMS(0, 3072, gw, ngw) } else { CONVERT_ITEMS(0, 22784, gw, ngw) }
            __syncthreads();
            rms_rows(ARG_IN(0), ARG_IN(1), H0, out + (size_t)MP * D, nullptr, 0, (LAS float*)(lds + 8 * 8448), gw, ngw, lane);
        } else if (ph == 2) {
            conv_phase(BCV, ARG_IN(2), ARG_IN(8), GB, out + O_CP, out + O_CS, gtid, nthreads);
        } else if (ph == 4 || ph == 7 || ph == 12) {
            rms_rows(out, out + (size_t)MP * D, ph == 4 ? H1 : (ph == 7 ? H2 : H3), out + (size_t)MP * D, (const float*)(ws + WS_PART), ph == 7 ? 16 : 8, (LAS float*)(lds + 8 * 8448), gw, ngw, lane);
        } else if (ph == 15) {
            reduce_sample(out + (size_t)MP * D, (const float*)(ws + WS_PART), 16, gw, ngw, lane);
        } else if (ph == 9) {
            PostArgs P{QKV, ARG_IN(12), ARG_IN(13), ARG_IN(3), ARG_IN(4), QB, KP, VTP, KS, VTS, out};
            post_phase(P, gw, ngw, lane, gtid, nthreads, tails ? 1 : 3);
        } else if (ph == 10) {
            attn_phase(lds, QB, KP, VTP, KS, VTS, ARG_IN(14), OB, G);
            sample_attn(QB, KS, VTS, ARG_IN(14), OB, gw, ngw, lane);
        } else {
#define RUN_BF16(ACT, ID, Aptr, Bptr, NN, KK, OUT) { const pg8::Gemm gg{Aptr, Bptr, M, NN, KK}; pg8::StaticOrderT<M, NN, KK> S; S.G = G; S.c = (int)blockIdx.x; const pg8::EpiBf16<ACT, ID> E{OUT, NN}; \
                pg8::gemm_phase<pg8::EpiBf16<ACT, ID>, pg8::StaticOrderT<M, NN, KK>, true, true>(lds, gg, S, E); }
#define RUN_RES(ID, Aptr, Bptr, KK, NS, SRCP) { const pg8::Gemm gg{Aptr, Bptr, M, D, KK}; pg8::SplitOrderT<KK, NS> S; S.G = G; S.c = (int)blockIdx.x; const pg8::EpiRes<ID> E{SRCP, out, (float*)(ws + WS_PART)}; \
                pg8::gemm_phase<pg8::EpiRes<ID>, pg8::SplitOrderT<KK, NS>, true, true>(lds, gg, S, E); }
            if (ph == 1) RUN_BF16(0, 1, H0, WT[0], NIN, D, BCV)
            else if (ph == 3) RUN_RES(3, GB, WT[1], D, 8, ARG_IN(0))
            else if (ph == 5) RUN_BF16(1, 5, H1, WT[4], FF, D, AB)
            else if (ph == 6) RUN_RES(6, AB, WT[6], FF, 16, nullptr)
            else if (ph == 8) RUN_BF16(0, 8, H2, WT[2], NQKV, D, QKV)
            else if (ph == 11) RUN_RES(11, OB, WT[3], D, 8, nullptr)
            else if (ph == 13) RUN_BF16(1, 13, H3, WT[5], FF, D, AB)
            else RUN_RES(14, AB, WT[7], FF, 16, nullptr)
#undef RUN_BF16
#undef RUN_RES
            if (tails && ph == 1 && blockIdx.x >= 24) { const int hw = ((int)blockIdx.x - 24) * NWAVES + wave, nhw = (G - 24) * NWAVES;
                CONVERT_ITEMS(3072, 4096, hw, nhw) CONVERT_ITEMS(6400, 10496, hw, nhw) CONVERT_ITEMS(14592, 18688, hw, nhw) }
            if (tails && ph == 8 && blockIdx.x >= 74) {
                PostArgs P{QKV, ARG_IN(12), ARG_IN(13), ARG_IN(3), ARG_IN(4), QB, KP, VTP, KS, VTS, out};
                post_phase(P, 0, 1, lane, ((int)blockIdx.x - 74) * NTHREADS + tid, (G - 74) * NTHREADS, 2); }
            if (tails && ph == 5 && blockIdx.x >= 32) { const int hw = ((int)blockIdx.x - 32) * NWAVES + wave, nhw = (G - 32) * NWAVES;
                CONVERT_ITEMS(4096, 6400, hw, nhw) CONVERT_ITEMS(10496, 14592, hw, nhw) CONVERT_ITEMS(18688, 22784, hw, nhw) }
        }
        if (a.ph_lo == 0 && (ph != a.ph_hi || DBG_PH != 15)) {
            XcdBarrier xb; xb.bar = (unsigned*)(ws + WS_BAR); xb.x = xb_xcc_id(); xb.st = (volatile LAS unsigned*)(lds + LDS_RING);
            xcd_barrier(xb);
        } else
        if (ph != a.ph_hi || DBG_PH != 15) {
            asm volatile("s_waitcnt vmcnt(0)" ::: "memory");
            __syncthreads();
            if (threadIdx.x == 0) { __builtin_amdgcn_fence(__ATOMIC_RELEASE, "agent"); asm volatile("s_waitcnt vmcnt(0)" ::: "memory"); }
            grid.sync();
            if (threadIdx.x == 0) { __builtin_amdgcn_fence(__ATOMIC_ACQUIRE, "agent"); asm volatile("s_waitcnt vmcnt(0)" ::: "memory"); }
            __syncthreads();
        }
    }
#if DBG_PH != 15
    {
        const int gtid = blockIdx.x * NTHREADS + threadIdx.x; unsigned char* ws = (unsigned char*)karg_ptr<144>(); float* out = (float*)karg_ptr<136>();
        const unsigned* w0 = (const unsigned*)(ws); const unsigned* w1 = (const unsigned*)(ws + WS_H); const unsigned* w2 = (const unsigned*)(ws + WS_R);
        unsigned x0 = 0, x1 = 0, x2 = 0;
        for (size_t i = gtid; i < (178 * MiB) / 4; i += nthreads) x0 ^= w0[i];
        for (size_t i = gtid; i < (33 * MiB) / 4; i += nthreads) x1 ^= w1[i];
        for (size_t i = gtid; i < (174 * MiB) / 4; i += nthreads) x2 ^= w2[i];
        out[O_KS + gtid] = (float)((x0 ^ (x0 >> 12)) & 0xfffffu); out[O_KS + nthreads + gtid] = (float)((x1 ^ (x1 >> 12)) & 0xfffffu); out[O_KS + 2 * nthreads + gtid] = (float)((x2 ^ (x2 >> 12)) & 0xfffffu);
    }
#endif
}

extern "C" void kernel_launch(void* const* d_in, const int* in_sizes, int n_in, void* d_out, int out_size, void* d_ws, size_t ws_size, hipStream_t stream) {
    static int grid_blocks = 0;
    if (grid_blocks == 0) {
        if (n_in != 17 || ws_size < WS_END) { fprintf(stderr, "kernel_launch: unexpected inputs (n_in %d, ws %zu)\n", n_in, ws_size); grid_blocks = -1; return; }
        int dev = 0, cus = 0, per_cu = 0;
        if (hipGetDevice(&dev) != hipSuccess || hipDeviceGetAttribute(&cus, hipDeviceAttributeMultiprocessorCount, dev) != hipSuccess) { grid_blocks = -1; return; }
        if (hipFuncSetAttribute((const void*)fwd_megakernel, hipFuncAttributeMaxDynamicSharedMemorySize, LDS_BYTES) != hipSuccess) { fprintf(stderr, "kernel_launch: hipFuncSetAttribute failed\n"); grid_blocks = -1; return; }
        if (hipOccupancyMaxActiveBlocksPerMultiprocessor(&per_cu, (const void*)fwd_megakernel, NTHREADS, LDS_BYTES) != hipSuccess || per_cu < 1) { fprintf(stderr, "kernel_launch: occupancy query reports %d blocks per CU\n", per_cu); grid_blocks = -1; return; }
        grid_blocks = cus;
    }
    if (grid_blocks < 0) return;
    Args a{};
    for (int i = 0; i < 17; ++i) a.in[i] = (const float*)d_in[i];
    a.out = (float*)d_out; a.ws = (unsigned char*)d_ws;
#ifndef MK_LAUNCHES
#define MK_LAUNCHES 1
#endif
    if (hipMemsetAsync((char*)d_ws + WS_BAR, 0, 16384, stream) != hipSuccess) { fprintf(stderr, "kernel_launch: hipMemsetAsync of the barrier words failed\n"); return; }
    void* args[] = {&a};
    if (MK_LAUNCHES == 1) {
        a.ph_lo = 0; a.ph_hi = DBG_PH;
        hipError_t e = hipLaunchCooperativeKernel((const void*)fwd_megakernel, dim3(grid_blocks), dim3(NTHREADS), args, LDS_BYTES, stream);
        if (e != hipSuccess) fprintf(stderr, "cooperative launch failed: %s (grid %d)\n", hipGetErrorString(e), grid_blocks);
    } else {
        for (int ph = 0; ph <= DBG_PH; ++ph) {
            a.ph_lo = ph; a.ph_hi = ph;
            hipError_t e = hipLaunchCooperativeKernel((const void*)fwd_megakernel, dim3(grid_blocks), dim3(NTHREADS), args, LDS_BYTES, stream);
            if (e != hipSuccess) { fprintf(stderr, "launch %d failed: %s\n", ph, hipGetErrorString(e)); break; }
        }
    }
}
```

```cpp
#include <hip/hip_runtime.h>
#include <hip/hip_cooperative_groups.h>
#include <cstdio>
#include <cstdint>
namespace cg = cooperative_groups;
namespace pg8 {
#define PG8_LAS __attribute__((address_space(3)))
typedef unsigned short bf16_t;
typedef short bf16x8 __attribute__((ext_vector_type(8)));
typedef float f32x4 __attribute__((ext_vector_type(4)));
typedef unsigned u32x4 __attribute__((ext_vector_type(4)));
constexpr int BM = 256, BK = 64, HALF = 128, HTB = HALF * BK * 2  , STAGE_BYTES = 8 * HTB, NXCD = 8, WGM = 8;

__host__ __device__ __forceinline__ int lds_byte(int r, int c) { const int st = (r >> 4) * 2 + (c >> 5), rr = r & 15, cc = c & 31, ob = rr * 64 + cc * 2; return st * 1024 + (ob ^ (((ob >> 9) & 1) << 5)); }
__host__ __device__ __forceinline__ void stage_rc(int b, int& R, int& C) { const int st = b / 1024, sb = b % 1024, swz = sb ^ (((sb >> 9) & 1) << 5); R = (st >> 1) * 16 + swz / 64; C = (st & 1) * 32 + (swz % 64) / 2; }
__host__ __device__ __forceinline__ int perm32(int rho) { const int n = rho >> 4, i = rho & 15; return 8 * (i >> 2) + 4 * n + (i & 3); }

struct Unit { int pm, pn, nt, split; };
struct Gemm { const bf16_t* A; const bf16_t* Bt; int M, N, K; };

template <int M_, int N_, int K_> struct StaticOrderT {
    static constexpr int KDIM = K_, nM = M_ / BM, nN = N_ / BM, nwg = nM * nN, ntk = K_ / BK;
    int G, c;
    __device__ __forceinline__ bool next(int i, Unit& u) const { const long L = (long)i * G + c; if (L >= nwg) return false; map((int)L, u); return true; }
    static __device__ __forceinline__ void map(int L, Unit& u) {
        u.nt = ntk; u.split = 0;
        int wgid = L; { constexpr int q = nwg / NXCD, r = nwg % NXCD; const int xcd = wgid % NXCD, off = wgid / NXCD; wgid = (xcd < r ? xcd * (q + 1) : r * (q + 1) + (xcd - r) * q) + off; }
        constexpr int nig = WGM * nN; const int gid = wgid / nig, fm = gid * WGM, gsz = (nM - fm) < WGM ? (nM - fm) : WGM;
        u.pm = fm + ((wgid % nig) % gsz); u.pn = (wgid % nig) / gsz;
    }
    __device__ __forceinline__ void a_ready(const Unit&) const {}
    __device__ __forceinline__ void done(const Unit&) const {}
};
template <int K_, int NS> struct SplitOrderT {
    typedef StaticOrderT<8192, 2048, K_> Base;
    static constexpr int KDIM = K_, ntS = K_ / BK / NS;
    int G, c;
    __device__ __forceinline__ bool next(int i, Unit& u) const {
        const int L = i * G + c; const bool isb = L < Base::nwg; const int j = L - Base::nwg;
        Unit b; Base::map(isb ? L : 0, b);
        u.pm = isb ? b.pm : Base::nM; u.pn = isb ? b.pn : (j % Base::nN); u.split = isb ? 0 : (j / Base::nN); u.nt = isb ? Base::ntk : ntS;
        return isb || j < Base::nN * NS;
    }
    __device__ __forceinline__ void a_ready(const Unit&) const {}
    __device__ __forceinline__ void done(const Unit&) const {}
};

__device__ __forceinline__ unsigned cvt_pk_bf16(float lo, float hi) { unsigned r; asm volatile("v_cvt_pk_bf16_f32 %0, %1, %2" : "=v"(r) : "v"(lo), "v"(hi)); return r; }
template <int ACT  , int ID = 0  > struct EpiBf16 {
    static constexpr bool PERM = true, AFTER_DRAIN = false;
    bf16_t* O; int ldc; const float* rowss;
    __device__ __forceinline__ void operator()(const f32x4 (&acc)[2][2][4][2], const Unit& u, int wr, int wc, int fr, int fq) const {
        asm volatile("" : "+v"(fr), "+v"(fq));
        const int row0 = u.pm * BM + wr * 64 + fr; const int col0 = u.pn * BM + wc * 32 + 8 * fq;
#pragma unroll
        for (int ai = 0; ai < 2; ++ai)
#pragma unroll
            for (int m = 0; m < 4; ++m) { bf16_t* rowp = O + (size_t)(row0 + ai * HALF + m * 16) * ldc + col0;
                float rs = 1.0f; if (rowss != nullptr) rs = 1.0f / sqrtf(rowss[row0 + ai * HALF + m * 16] * (1.0f / 2048.0f) + 1e-6f);
#pragma unroll
                for (int bj = 0; bj < 2; ++bj) { f32x4 v0 = acc[ai][bj][m][0] * rs, v1 = acc[ai][bj][m][1] * rs;
                    if (ACT == 1) {
#pragma unroll
                        for (int e = 0; e < 4; ++e) { const float a = fmaxf(v0[e], 0.f), b = fmaxf(v1[e], 0.f); v0[e] = a * a; v1[e] = b * b; } }
                    u32x4 w; w.x = cvt_pk_bf16(v0[0], v0[1]); w.y = cvt_pk_bf16(v0[2], v0[3]); w.z = cvt_pk_bf16(v1[0], v1[1]); w.w = cvt_pk_bf16(v1[2], v1[3]);
                    *(u32x4*)(rowp + bj * HALF) = w; } }
    }
};
template <int ID, int MODE> struct EpiRes2 {
    static constexpr bool PERM = true, AFTER_DRAIN = false;
    const float* srcF; bf16_t* yb; float* dstF; float* part; float* rowss;
    __device__ __forceinline__ void operator()(const f32x4 (&acc)[2][2][4][2], const Unit& u, int wr, int wc, int fr, int fq) const {
        asm volatile("" : "+v"(fr), "+v"(fq));
        const bool sp = u.pm >= 32;
        const int colb = u.pn * BM + wc * 32 + 8 * fq;
        if (sp) {
            float* P = part + (size_t)u.split * (BM * 2048) + colb;
#pragma unroll
            for (int ai = 0; ai < 2; ++ai)
#pragma unroll
                for (int m = 0; m < 4; ++m) { float* rp = P + (ai * HALF + wr * 64 + m * 16 + fr) * 2048;
#pragma unroll
                    for (int bj = 0; bj < 2; ++bj) { *(f32x4*)(rp + bj * HALF) = acc[ai][bj][m][0]; *(f32x4*)(rp + bj * HALF + 4) = acc[ai][bj][m][1]; } }
            return;
        }
        const size_t tbase = (size_t)u.pm * (BM * 2048) + colb;
#pragma unroll
        for (int ai = 0; ai < 2; ++ai)
#pragma unroll
            for (int m = 0; m < 4; ++m) { const int rl = ai * HALF + wr * 64 + m * 16 + fr; const size_t off = tbase + (size_t)rl * 2048;
                f32x4 y[2][2];
                if (MODE == 0) {
#pragma unroll
                    for (int bj = 0; bj < 2; ++bj) { y[bj][0] = *(const f32x4*)(srcF + off + bj * HALF); y[bj][1] = *(const f32x4*)(srcF + off + bj * HALF + 4); }
                } else {
#pragma unroll
                    for (int bj = 0; bj < 2; ++bj) { const u32x4 w = *(const u32x4*)(yb + off + bj * HALF);
                        y[bj][0] = (f32x4){__uint_as_float(w.x << 16), __uint_as_float(w.x & 0xffff0000u), __uint_as_float(w.y << 16), __uint_as_float(w.y & 0xffff0000u)};
                        y[bj][1] = (f32x4){__uint_as_float(w.z << 16), __uint_as_float(w.z & 0xffff0000u), __uint_as_float(w.w << 16), __uint_as_float(w.w & 0xffff0000u)}; }
                }
                float s = 0.f;
#pragma unroll
                for (int bj = 0; bj < 2; ++bj) {
                    y[bj][0] += acc[ai][bj][m][0]; y[bj][1] += acc[ai][bj][m][1];
                    if (MODE == 2) { *(f32x4*)(dstF + off + bj * HALF) = y[bj][0]; *(f32x4*)(dstF + off + bj * HALF + 4) = y[bj][1]; }
                    else { const f32x4 a = y[bj][0], b = y[bj][1];
                        u32x4 w; w.x = cvt_pk_bf16(a[0], a[1]); w.y = cvt_pk_bf16(a[2], a[3]); w.z = cvt_pk_bf16(b[0], b[1]); w.w = cvt_pk_bf16(b[2], b[3]);
                        *(u32x4*)(yb + off + bj * HALF) = w;
                        const float r0 = __uint_as_float(w.x << 16), r1 = __uint_as_float(w.x & 0xffff0000u), r2 = __uint_as_float(w.y << 16), r3 = __uint_as_float(w.y & 0xffff0000u);
                        const float r4 = __uint_as_float(w.z << 16), r5 = __uint_as_float(w.z & 0xffff0000u), r6 = __uint_as_float(w.w << 16), r7 = __uint_as_float(w.w & 0xffff0000u);
                        s += ((r0 * r0 + r1 * r1) + (r2 * r2 + r3 * r3)) + ((r4 * r4 + r5 * r5) + (r6 * r6 + r7 * r7)); }
                }
                if (MODE != 2) {
                    const int ln = fr + 16 * fq;
                    s += __int_as_float(__builtin_amdgcn_ds_bpermute((ln ^ 16) << 2, __float_as_int(s)));
                    s += __int_as_float(__builtin_amdgcn_ds_bpermute((ln ^ 32) << 2, __float_as_int(s)));
                    if (fq == 0) (void)__hip_atomic_fetch_add((__attribute__((address_space(1))) float*)(rowss + (u.pm * BM + rl)), s, __ATOMIC_RELAXED, __HIP_MEMORY_SCOPE_AGENT);
                }
                asm volatile("" ::: "memory"); }
    }
};

template <class Epi, class Sched, bool ALIGN_EPI = false, bool SP2 = false>
__device__ __forceinline__ void gemm_phase(PG8_LAS unsigned char* lds, const Gemm g, const Sched& S, const Epi& E) {
    int tid_ = threadIdx.x; asm volatile("" : "+v"(tid_)); const int tid = tid_, wid = __builtin_amdgcn_readfirstlane(tid >> 6), lane = tid & 63, wr = wid >> 2, wc = wid & 3, fr = lane & 15, fq = lane >> 4;
    constexpr int K = Sched::KDIM;
    unsigned voffA[2], voffB[2];
#pragma unroll
    for (int i = 0; i < 2; ++i) { int R, C; stage_rc(tid * 16 + i * 8192, R, C); const int Rb = Epi::PERM ? ((R & ~31) + perm32(R & 31)) : R;
        voffA[i] = (unsigned)(R * K + C) * 2u; voffB[i] = (unsigned)(Rb * K + C) * 2u; }
    const size_t kstep = (size_t)(BK * 2);
    const size_t hstep = (size_t)HALF * K * 2;
    const size_t tstep = 2 * hstep;
    const unsigned ldsw = (unsigned)wid * 1024u;
    const int aoff = lds_byte(wr * 64 + fr, fq * 8), boff = lds_byte(wc * 32 + fr, fq * 8);
#define PG8_SA(b, h) (((b) * 2 + (h)) * HTB)
#define PG8_SB(b, h) ((4 + (b) * 2 + (h)) * HTB)
#define PG8_STAGE(bufoff, gbase, voff) do { _Pragma("unroll") for (int _i = 0; _i < 2; ++_i) \
        __builtin_amdgcn_global_load_lds((const unsigned*)((const char*)(gbase) + (voff)[_i]), (PG8_LAS unsigned*)(lds + (bufoff) + ldsw + _i * 8192), 16, 0, 0); } while (0)
#define PG8_LDA(dst, b, h) do { _Pragma("unroll") for (int m = 0; m < 4; ++m) _Pragma("unroll") for (int k = 0; k < 2; ++k) dst[m][k] = *(const PG8_LAS bf16x8*)(lds + PG8_SA(b, h) + aoff + m * 2048 + k * 1024); } while (0)
#define PG8_LDB(dst, b, h) do { _Pragma("unroll") for (int n = 0; n < 2; ++n) _Pragma("unroll") for (int k = 0; k < 2; ++k) dst[n][k] = *(const PG8_LAS bf16x8*)(lds + PG8_SB(b, h) + boff + n * 2048 + k * 1024); } while (0)
#define PG8_MMA(ai, bj, At, Bt) do { __builtin_amdgcn_s_setprio(1); _Pragma("unroll") for (int m = 0; m < 4; ++m) _Pragma("unroll") for (int n = 0; n < 2; ++n) _Pragma("unroll") for (int k = 0; k < 2; ++k) \
        acc[ai][bj][m][n] = __builtin_amdgcn_mfma_f32_16x16x32_bf16(Bt[n][k], At[m][k], acc[ai][bj][m][n], 0, 0, 0); __builtin_amdgcn_s_setprio(0); } while (0)
#define PG8_WAIT_V(n) asm volatile("s_waitcnt vmcnt(" #n ")" ::: "memory")
#define PG8_WAIT_L(n) asm volatile("s_waitcnt lgkmcnt(" #n ")" ::: "memory")
#define PG8_BAR __builtin_amdgcn_s_barrier()
#define PG8_SCHED __builtin_amdgcn_sched_barrier(0)
    Unit cur, nxt; int ui = 0;
    if (!S.next(0, cur)) return;
    f32x4 acc[2][2][4][2];
#pragma unroll
    for (int a = 0; a < 2; ++a)
#pragma unroll
        for (int b = 0; b < 2; ++b)
#pragma unroll
            for (int m = 0; m < 4; ++m)
#pragma unroll
                for (int n = 0; n < 2; ++n) acc[a][b][m][n] = (f32x4){0.f, 0.f, 0.f, 0.f};
    bf16x8 At[4][2], B0[2][2], B1[2][2];
    const char* cA = (const char*)g.A + (size_t)cur.pm * tstep + (size_t)(cur.split * cur.nt) * kstep; const char* cB = (const char*)g.Bt + (size_t)cur.pn * tstep + (size_t)(cur.split * cur.nt) * kstep;
    S.a_ready(cur);
    if constexpr (SP2) {
        PG8_STAGE(PG8_SB(0, 0), cB, voffB); PG8_STAGE(PG8_SB(0, 1), cB + hstep, voffB); PG8_STAGE(PG8_SA(0, 0), cA, voffA); PG8_STAGE(PG8_SA(0, 1), cA + hstep, voffA);
        if (wr == 1) PG8_BAR;
        PG8_WAIT_V(2); PG8_BAR;
        PG8_STAGE(PG8_SB(1, 0), cB + kstep, voffB); PG8_STAGE(PG8_SA(1, 0), cA + kstep, voffA); PG8_STAGE(PG8_SB(1, 1), cB + hstep + kstep, voffB);
        PG8_WAIT_V(6); PG8_BAR;
    } else {
        PG8_STAGE(PG8_SB(0, 0), cB, voffB); PG8_STAGE(PG8_SA(0, 0), cA, voffA); PG8_STAGE(PG8_SB(0, 1), cB + hstep, voffB); PG8_STAGE(PG8_SA(0, 1), cA + hstep, voffA);
        if (wr == 1) PG8_BAR;
        PG8_WAIT_V(4); PG8_BAR;
        PG8_STAGE(PG8_SB(1, 0), cB + kstep, voffB); PG8_STAGE(PG8_SA(1, 0), cA + kstep, voffA); PG8_STAGE(PG8_SB(1, 1), cB + hstep + kstep, voffB);
        PG8_WAIT_V(6); PG8_BAR;
    }
    for (;;) {
        const bool has_next = S.next(ui + 1, nxt);
        const char* nA = has_next ? (const char*)g.A + (size_t)nxt.pm * tstep + (size_t)(nxt.split * nxt.nt) * kstep : cA; const char* nB = has_next ? (const char*)g.Bt + (size_t)nxt.pn * tstep + (size_t)(nxt.split * nxt.nt) * kstep : cB;
        const int nt = cur.nt;
        for (int t = 0; t < nt; t += 2) {
            const bool last = (t == nt - 2);
            const char* a1 = cA + (size_t)(t + 1) * kstep;
            const char* a2 = last ? nA : cA + (size_t)(t + 2) * kstep; const char* b2 = last ? nB : cB + (size_t)(t + 2) * kstep;
            const char* a3 = a2 + kstep; const char* b3 = b2 + kstep;
            if (last && has_next) S.a_ready(nxt);
            if constexpr (SP2) {
            PG8_LDB(B0, 0, 0); PG8_LDB(B1, 0, 1); PG8_SCHED; PG8_LDA(At, 0, 0); PG8_STAGE(PG8_SA(1, 1), a1 + hstep, voffA);
            PG8_WAIT_V(8); PG8_WAIT_L(0); PG8_BAR; PG8_MMA(0, 0, At, B0); PG8_MMA(0, 1, At, B1); PG8_BAR; PG8_SCHED;
            PG8_LDA(At, 0, 1); PG8_STAGE(PG8_SB(0, 0), b2, voffB); PG8_STAGE(PG8_SB(0, 1), b2 + hstep, voffB); PG8_STAGE(PG8_SA(0, 0), a2, voffA);
            PG8_WAIT_V(8); PG8_WAIT_L(0); PG8_BAR; PG8_MMA(1, 0, At, B0); PG8_MMA(1, 1, At, B1); PG8_BAR; PG8_SCHED;
            PG8_LDB(B0, 1, 0); PG8_LDB(B1, 1, 1); PG8_SCHED; PG8_LDA(At, 1, 0); PG8_STAGE(PG8_SA(0, 1), a2 + hstep, voffA);
            PG8_WAIT_V(8); PG8_WAIT_L(0); PG8_BAR; PG8_MMA(0, 0, At, B0); PG8_MMA(0, 1, At, B1); PG8_BAR; PG8_SCHED;
            PG8_LDA(At, 1, 1); PG8_STAGE(PG8_SB(1, 0), b3, voffB); PG8_STAGE(PG8_SB(1, 1), b3 + hstep, voffB); PG8_STAGE(PG8_SA(1, 0), a3, voffA);
            PG8_WAIT_V(8); PG8_WAIT_L(0); PG8_BAR; PG8_MMA(1, 0, At, B0); PG8_MMA(1, 1, At, B1); PG8_BAR; PG8_SCHED;
            } else {
            PG8_LDB(B0, 0, 0); PG8_SCHED; PG8_LDA(At, 0, 0); PG8_STAGE(PG8_SA(1, 1), a1 + hstep, voffA);
            PG8_WAIT_L(8); PG8_BAR; PG8_WAIT_L(0); PG8_MMA(0, 0, At, B0); PG8_BAR; PG8_SCHED;
            PG8_LDB(B1, 0, 1); PG8_STAGE(PG8_SB(0, 0), b2, voffB);
            PG8_BAR; PG8_WAIT_L(0); PG8_MMA(0, 1, At, B1); PG8_BAR;
            PG8_LDA(At, 0, 1); PG8_STAGE(PG8_SA(0, 0), a2, voffA);
            PG8_BAR; PG8_WAIT_L(0); PG8_MMA(1, 0, At, B0); PG8_BAR; PG8_SCHED;
            PG8_STAGE(PG8_SB(0, 1), b2 + hstep, voffB);
            PG8_WAIT_V(6); PG8_BAR; PG8_MMA(1, 1, At, B1); PG8_BAR;
            PG8_LDB(B0, 1, 0); PG8_SCHED; PG8_LDA(At, 1, 0); PG8_STAGE(PG8_SA(0, 1), a2 + hstep, voffA);
            PG8_WAIT_L(8); PG8_BAR; PG8_WAIT_L(0); PG8_MMA(0, 0, At, B0); PG8_BAR; PG8_SCHED;
            PG8_LDB(B1, 1, 1); PG8_STAGE(PG8_SB(1, 0), b3, voffB);
            PG8_BAR; PG8_WAIT_L(0); PG8_MMA(0, 1, At, B1); PG8_BAR;
            PG8_LDA(At, 1, 1); PG8_STAGE(PG8_SA(1, 0), a3, voffA);
            PG8_BAR; PG8_WAIT_L(0); PG8_MMA(1, 0, At, B0); PG8_BAR; PG8_SCHED;
            PG8_STAGE(PG8_SB(1, 1), b3 + hstep, voffB);
            PG8_WAIT_V(6); PG8_BAR; PG8_MMA(1, 1, At, B1); PG8_BAR;
            }
        }
        if constexpr (ALIGN_EPI) { if (wr == 0) PG8_BAR; }
        if constexpr (!Epi::AFTER_DRAIN) { E(acc, cur, wr, wc, fr, fq); S.done(cur); }
        if (!has_next) break;
#pragma unroll
        for (int a = 0; a < 2; ++a)
#pragma unroll
            for (int b = 0; b < 2; ++b)
#pragma unroll
                for (int m = 0; m < 4; ++m)
#pragma unroll
                    for (int n = 0; n < 2; ++n) acc[a][b][m][n] = (f32x4){0.f, 0.f, 0.f, 0.f};
        cur = nxt; cA = nA; cB = nB; ++ui;
        if constexpr (ALIGN_EPI) { if (wr == 1) PG8_BAR; }
    }
    PG8_WAIT_V(0);
    if constexpr (!ALIGN_EPI) { if (wr == 0) PG8_BAR; }
    PG8_BAR;
    if constexpr (Epi::AFTER_DRAIN) { E.fused(acc, cur, wr, wc, fr, fq, lds, wid, lane); S.done(cur); }
#undef PG8_SA
#undef PG8_SB
#undef PG8_STAGE
#undef PG8_LDA
#undef PG8_LDB
#undef PG8_MMA
#undef PG8_WAIT_V
#undef PG8_WAIT_L
#undef PG8_BAR
#undef PG8_SCHED
}
}
constexpr int D = 2048, SEQ = 4096, NBATCH = 2, MP = NBATCH * SEQ, DEC_B = 32, DEC_T = 8, MS = DEC_B * DEC_T, M = MP + MS;
constexpr int FF = 8192, NIN = 3 * D, HD = 64, NH = 32, NKV = 4, KVW = NKV * HD, NQKV = NH * HD + 2 * KVW, PAST = 16384, WIN = 128;
constexpr int SKF = WIN + DEC_T;
constexpr int SVP = 144;
constexpr float EPS = 1e-6f, LOG2E = 1.4426950408889634f, QSCALE = 0.125f * LOG2E;
constexpr size_t O_CP = (size_t)M * D, O_CS = O_CP + (size_t)NBATCH * 2 * D, O_KP = O_CS + (size_t)DEC_B * 2 * D, O_VP = O_KP + (size_t)NBATCH * WIN * KVW,
                 O_KS = O_VP + (size_t)NBATCH * WIN * KVW, O_VS = O_KS + (size_t)DEC_B * WIN * KVW;
constexpr size_t MiB = 1u << 20;
constexpr size_t WS_WIN = 0, WS_WOUT = 24 * MiB, WS_WQKV = 32 * MiB, WS_WATT = 42 * MiB, WS_WUP0 = 50 * MiB, WS_WUP1 = 82 * MiB, WS_WDN0 = 114 * MiB, WS_WDN1 = 146 * MiB;
constexpr size_t WS_H = 180 * MiB, WS_R = 214 * MiB, WS_A = WS_R, WS_BCV = WS_R, WS_G = WS_R + 99 * MiB, WS_QKV = WS_R + 132 * MiB  , WS_Q = WS_R + 42 * MiB, WS_O = WS_R + 75 * MiB;
constexpr size_t WS_KP = WS_R + 108 * MiB, WS_VTP = WS_R + 112 * MiB, WS_KS = WS_R + 116 * MiB, WS_VTS = WS_R + 119 * MiB, WS_HX = WS_R + 174 * MiB  , WS_END = WS_HX + 99 * MiB;
static_assert((size_t)8448 * 6144 * 2 <= 99 * MiB && (size_t)8448 * 8192 * 2 <= 132 * MiB && (size_t)8448 * 2560 * 2 <= 42 * MiB && (size_t)8448 * 2048 * 2 <= 33 * MiB, "ws map");
constexpr size_t WS_PART = WS_QKV;
constexpr size_t WS_BAR = 178 * MiB;
constexpr size_t WS_RSS = 178 * MiB + 65536;
constexpr int LDS_RING = 131072, LDS_BYTES = LDS_RING + 64;
constexpr int NTHREADS = 512, NWAVES = 8;

#define LAS __attribute__((address_space(3)))
typedef unsigned short bf16;
typedef float f32x4 __attribute__((ext_vector_type(4)));
typedef unsigned u32x4 __attribute__((ext_vector_type(4)));
typedef unsigned u32x2 __attribute__((ext_vector_type(2)));
typedef short bf16x8 __attribute__((ext_vector_type(8)));
__device__ __forceinline__ float bf2f(unsigned v) { return __uint_as_float(v << 16); }
__device__ __forceinline__ float bflo(unsigned w) { return __uint_as_float(w << 16); }
__device__ __forceinline__ float bfhi(unsigned w) { return __uint_as_float(w & 0xffff0000u); }
__device__ __forceinline__ unsigned pk2(float lo, float hi) { return pg8::cvt_pk_bf16(lo, hi); }
__device__ __forceinline__ float shx(float v, int o, int lane) { return __int_as_float(__builtin_amdgcn_ds_bpermute((lane ^ o) << 2, __float_as_int(v))); }
__device__ __forceinline__ float wave_sum(float v, int lane) {
#pragma unroll
    for (int o = 1; o < 64; o <<= 1) v += shx(v, o, lane);
    return v;
}
__device__ const double ROPE_INV[32] = {1.0, 0.7498942093324559, 0.5623413251903491, 0.4216965034285822, 0.31622776601683794, 0.23713737056616552, 0.1778279410038923, 0.1333521432163324,
    0.1, 0.07498942093324558, 0.05623413251903491, 0.042169650342858224, 0.03162277660168379, 0.023713737056616554, 0.01778279410038923, 0.01333521432163324,
    0.01, 0.007498942093324558, 0.005623413251903491, 0.004216965034285823, 0.0031622776601683794, 0.0023713737056616554, 0.0017782794100389228, 0.001333521432163324,
    0.001, 0.0007498942093324559, 0.0005623413251903491, 0.00042169650342858224, 0.00031622776601683794, 0.00023713737056616554, 0.00017782794100389227, 0.0001333521432163324};

__device__ __forceinline__ void transpose_item(const float* __restrict__ W, const float* __restrict__ gain, bf16* __restrict__ WT, int K, int N, int item, LAS unsigned* T, int lane) {
    const int nblk = N >> 6, kb = item / nblk, nb = item - kb * nblk, k0 = kb * 64, n0 = nb * 64;
    const int j = lane & 15, g = lane >> 4;
    const float* src = W + (size_t)(k0 + 2 * g) * N + n0 + 4 * j;
    f32x4 a[8], b[8];
#pragma unroll
    for (int i = 0; i < 8; ++i) { a[i] = *(const f32x4*)(src + (size_t)(8 * i) * N); b[i] = *(const f32x4*)(src + (size_t)(8 * i + 1) * N); }
    if (gain != nullptr) {
#pragma unroll
        for (int i = 0; i < 8; ++i) { const float ga = gain[k0 + 8 * i + 2 * g], gb = gain[k0 + 8 * i + 2 * g + 1]; a[i] = a[i] * ga; b[i] = b[i] * gb; }
    }
#pragma unroll
    for (int i = 0; i < 8; ++i) {
        const int r = 4 * i + g;
#pragma unroll
        for (int e = 0; e < 4; ++e) T[(4 * j + e) * 33 + r] = pk2(a[i][e], b[i][e]);
    }
    asm volatile("s_waitcnt lgkmcnt(0)" ::: "memory");
    const int c = lane & 7;
#pragma unroll
    for (int q = 0; q < 8; ++q) {
        const int n = (lane >> 3) + 8 * q; const LAS unsigned* s = T + n * 33 + 4 * c;
        u32x4 o; o.x = s[0]; o.y = s[1]; o.z = s[2]; o.w = s[3];
        *(u32x4*)(WT + (size_t)(n0 + n) * K + k0 + 8 * c) = o;
    }
    asm volatile("s_waitcnt lgkmcnt(0)" ::: "memory");
}

__device__ __forceinline__ void rms_load(f32x4 (&v)[8], const float* xr, int lane) {
#pragma unroll
    for (int j = 0; j < 4; ++j) { v[2 * j] = *(const f32x4*)(xr + j * 512 + lane * 8); v[2 * j + 1] = *(const f32x4*)(xr + j * 512 + lane * 8 + 4); }
}
__device__ __forceinline__ void rms_finish(const f32x4 (&v)[8], bf16* __restrict__ hr, int lane) {
    float ss = 0.f;
#pragma unroll
    for (int j = 0; j < 8; ++j) ss += (v[j][0] * v[j][0] + v[j][1] * v[j][1]) + (v[j][2] * v[j][2] + v[j][3] * v[j][3]);
    ss = wave_sum(ss, lane);
    const float rstd = 1.0f / sqrtf(ss * (1.0f / D) + EPS);
#pragma unroll
    for (int j = 0; j < 4; ++j) { const f32x4 p = v[2 * j] * rstd, q = v[2 * j + 1] * rstd; u32x4 o; o.x = pk2(p[0], p[1]); o.y = pk2(p[2], p[3]); o.z = pk2(q[0], q[1]); o.w = pk2(q[2], q[3]);
        *(u32x4*)(hr + j * 512 + lane * 8) = o; }
}
__device__ __forceinline__ void rms_rows(const float* srcP, const float* srcS, bf16* __restrict__ H, float* copyS, const float* part, int nsplit, LAS float* red, bool do_prompt, float* rowss_out, int gw, int ngw, int lane) {
    const int wave = gw & (NWAVES - 1), blk = gw >> 3, nblk = ngw >> 3;
    for (int sr = blk; sr < MS; sr += nblk) {
        const int c = wave * 256 + lane * 4;
        f32x4 v = *(const f32x4*)(srcS + (size_t)sr * D + c);
        if (part != nullptr) { const float* pr = part + (size_t)sr * D + c; f32x4 p[16];
#pragma unroll
            for (int s = 0; s < 16; ++s) p[s] = (s < nsplit) ? *(const f32x4*)(pr + (size_t)s * MS * D) : (f32x4){0.f, 0.f, 0.f, 0.f};
#pragma unroll
            for (int s = 0; s < 16; ++s) v += p[s]; }
        float ss = (v[0] * v[0] + v[1] * v[1]) + (v[2] * v[2] + v[3] * v[3]);
        ss = wave_sum(ss, lane);
        if (lane == 0) red[wave] = ss;
        __syncthreads();
        float tot = 0.f;
#pragma unroll
        for (int w = 0; w < NWAVES; ++w) tot += red[w];
        __syncthreads();
        const float rstd = (rowss_out == nullptr) ? 1.0f / sqrtf(tot * (1.0f / D) + EPS) : 1.0f;
        if (rowss_out != nullptr && wave == 0 && lane == 0) rowss_out[MP + sr] = tot;
        if (copyS != nullptr) *(f32x4*)(copyS + (size_t)sr * D + c) = v;
        u32x2 o; o.x = pk2(v[0] * rstd, v[1] * rstd); o.y = pk2(v[2] * rstd, v[3] * rstd);
        *(u32x2*)(H + (size_t)(MP + sr) * D + c) = o;
    }
    if (do_prompt) for (int row = gw; row < MP; row += 2 * ngw) {
        const int row2 = row + ngw; const bool two = row2 < MP;
        f32x4 a[8], b[8];
        rms_load(a, srcP + (size_t)row * D, lane);
        if (two) rms_load(b, srcP + (size_t)row2 * D, lane);
        rms_finish(a, H + (size_t)row * D, lane);
        if (two) rms_finish(b, H + (size_t)row2 * D, lane);
    }
}

__device__ __forceinline__ void reduce_sample(float* __restrict__ yS, const float* __restrict__ part, int nsplit, int gw, int ngw, int lane) {
    const int wave = gw & (NWAVES - 1), blk = gw >> 3, nblk = ngw >> 3;
    for (int sr = blk; sr < MS; sr += nblk) {
        const int c = wave * 256 + lane * 4; float* yr = yS + (size_t)sr * D + c;
        f32x4 v = *(const f32x4*)yr; const float* pr = part + (size_t)sr * D + c; f32x4 p[16];
#pragma unroll
        for (int s = 0; s < 16; ++s) p[s] = (s < nsplit) ? *(const f32x4*)(pr + (size_t)s * MS * D) : (f32x4){0.f, 0.f, 0.f, 0.f};
#pragma unroll
        for (int s = 0; s < 16; ++s) v += p[s];
        *(f32x4*)yr = v;
    }
}

__device__ __forceinline__ void unpack8(const u32x4 w, float (&f)[8]) { f[0] = bflo(w.x); f[1] = bfhi(w.x); f[2] = bflo(w.y); f[3] = bfhi(w.y); f[4] = bflo(w.z); f[5] = bfhi(w.z); f[6] = bflo(w.w); f[7] = bfhi(w.w); }
__device__ __forceinline__ void conv_phase(const bf16* __restrict__ bcv, const float* __restrict__ state, const float* __restrict__ wconv, bf16* __restrict__ G, float* __restrict__ out_cp, float* __restrict__ out_cs, int gtid, int nthreads) {
    for (int item = gtid; item < (M / 8) * 256; item += nthreads) {
        const int rb = item >> 8, dc = item & 255, d0 = dc * 8, r0 = rb * 8;
        float w0[8], w1[8], w2[8], up2[8], up1[8];
        { const f32x4 a = *(const f32x4*)(wconv + d0), b = *(const f32x4*)(wconv + d0 + 4), c = *(const f32x4*)(wconv + D + d0), d = *(const f32x4*)(wconv + D + d0 + 4), e = *(const f32x4*)(wconv + 2 * D + d0), f = *(const f32x4*)(wconv + 2 * D + d0 + 4);
#pragma unroll
          for (int k = 0; k < 4; ++k) { w0[k] = a[k]; w0[4 + k] = b[k]; w1[k] = c[k]; w1[4 + k] = d[k]; w2[k] = e[k]; w2[4 + k] = f[k]; } }
        const bool samp = r0 >= MP; const int sb = (r0 - MP) >> 3;
        if (samp) {
            const f32x4 a = *(const f32x4*)(state + (size_t)(sb * 2) * D + d0), b = *(const f32x4*)(state + (size_t)(sb * 2) * D + d0 + 4), c = *(const f32x4*)(state + (size_t)(sb * 2 + 1) * D + d0), d = *(const f32x4*)(state + (size_t)(sb * 2 + 1) * D + d0 + 4);
#pragma unroll
            for (int k = 0; k < 4; ++k) { up2[k] = a[k]; up2[4 + k] = b[k]; up1[k] = c[k]; up1[4 + k] = d[k]; }
        } else if ((r0 & (SEQ - 1)) == 0) {
#pragma unroll
            for (int k = 0; k < 8; ++k) { up2[k] = 0.f; up1[k] = 0.f; }
        } else {
            float c[8], v[8];
            unpack8(*(const u32x4*)(bcv + (size_t)(r0 - 2) * NIN + D + d0), c); unpack8(*(const u32x4*)(bcv + (size_t)(r0 - 2) * NIN + 2 * D + d0), v);
#pragma unroll
            for (int k = 0; k < 8; ++k) up2[k] = c[k] * v[k];
            unpack8(*(const u32x4*)(bcv + (size_t)(r0 - 1) * NIN + D + d0), c); unpack8(*(const u32x4*)(bcv + (size_t)(r0 - 1) * NIN + 2 * D + d0), v);
#pragma unroll
            for (int k = 0; k < 8; ++k) up1[k] = c[k] * v[k];
        }
#pragma unroll
        for (int rr = 0; rr < 8; ++rr) {
            const bf16* rp = bcv + (size_t)(r0 + rr) * NIN + d0;
            float bg[8], c[8], v[8], u[8], g[8];
            unpack8(*(const u32x4*)rp, bg); unpack8(*(const u32x4*)(rp + D), c); unpack8(*(const u32x4*)(rp + 2 * D), v);
#pragma unroll
            for (int k = 0; k < 8; ++k) { u[k] = c[k] * v[k]; g[k] = bg[k] * (w0[k] * up2[k] + w1[k] * up1[k] + w2[k] * u[k]); up2[k] = up1[k]; up1[k] = u[k]; }
            u32x4 o; o.x = pk2(g[0], g[1]); o.y = pk2(g[2], g[3]); o.z = pk2(g[4], g[5]); o.w = pk2(g[6], g[7]);
            *(u32x4*)(G + (size_t)(r0 + rr) * D + d0) = o;
        }
        float* op = nullptr;
        if (samp) op = out_cs + (size_t)(sb * 2) * D + d0;
        else if ((r0 & (SEQ - 1)) == SEQ - 8) op = out_cp + (size_t)((r0 >> 12) * 2) * D + d0;
        if (op != nullptr) {
            *(f32x4*)op = (f32x4){up2[0], up2[1], up2[2], up2[3]}; *(f32x4*)(op + 4) = (f32x4){up2[4], up2[5], up2[6], up2[7]};
            *(f32x4*)(op + D) = (f32x4){up1[0], up1[1], up1[2], up1[3]}; *(f32x4*)(op + D + 4) = (f32x4){up1[4], up1[5], up1[6], up1[7]};
        }
    }
}

struct PostArgs { const bf16* raw; const float* qn; const float* kn; const float* cache_k; const float* cache_v; bf16* Q; bf16* KP; bf16* VTP; bf16* KS; bf16* VTS; float* out; };
__device__ __forceinline__ void post_phase(const PostArgs& P, int gw, int ngw, int lane, int gtid, int nthreads, int parts  ) {
    if (parts & 1) {
        const int l8 = lane & 7, l4 = lane & 3; const bool first = l8 < 4;
        double inv[8]; float gq[8], gk[8];
#pragma unroll
        for (int e = 0; e < 8; ++e) { inv[e] = ROPE_INV[8 * l4 + e] * 0.15915494309189535; gq[e] = P.qn[8 * l8 + e]; gk[e] = P.kn[8 * l8 + e]; }
        for (int row = gw; row < M; row += ngw) {
            const bool samp = row >= MP; int b, t, pos;
            if (!samp) { b = row >> 12; t = row & (SEQ - 1); pos = t; } else { b = (row - MP) >> 3; t = (row - MP) & 7; pos = PAST + t; }
            const bf16* src = P.raw + (size_t)row * NQKV + 8 * lane;
            u32x4 ch[5];
#pragma unroll
            for (int j = 0; j < 5; ++j) ch[j] = *(const u32x4*)(src + 512 * j);
            float cs[8], sn[8];
#pragma unroll
            for (int e = 0; e < 8; ++e) { const double rev = (double)pos * inv[e]; const float fr = (float)(rev - __builtin_rint(rev)); sn[e] = __builtin_amdgcn_sinf(fr); cs[e] = __builtin_amdgcn_cosf(fr); }
#pragma unroll
            for (int j = 0; j < 5; ++j) {
                float x[8], o[8]; unpack8(ch[j], x);
                float ss = 0.f;
#pragma unroll
                for (int e = 0; e < 8; ++e) ss += x[e] * x[e];
                ss += shx(ss, 1, lane); ss += shx(ss, 2, lane); ss += shx(ss, 4, lane);
                const float rstd = 1.0f / sqrtf(ss * (1.0f / HD) + EPS);
#pragma unroll
                for (int e = 0; e < 8; ++e) { const float y = x[e] * rstd * (j < 4 ? gq[e] : gk[e]); const float py = shx(y, 4, lane); o[e] = first ? y * cs[e] - py * sn[e] : y * cs[e] + py * sn[e]; }
                if (j < 4) {
                    u32x4 w; w.x = pk2(o[0] * QSCALE, o[1] * QSCALE); w.y = pk2(o[2] * QSCALE, o[3] * QSCALE); w.z = pk2(o[4] * QSCALE, o[5] * QSCALE); w.w = pk2(o[6] * QSCALE, o[7] * QSCALE);
                    *(u32x4*)(P.Q + (size_t)row * D + 512 * j + 8 * lane) = w;
                } else if (lane < 32) {
                    u32x4 w; w.x = pk2(o[0], o[1]); w.y = pk2(o[2], o[3]); w.z = pk2(o[4], o[5]); w.w = pk2(o[6], o[7]);
                    float* op = nullptr;
                    if (!samp) { *(u32x4*)(P.KP + (size_t)row * KVW + 8 * lane) = w; if (t >= SEQ - WIN) op = P.out + O_KP + (size_t)(b * WIN + (t - (SEQ - WIN))) * KVW + 8 * lane; }
                    else { *(u32x4*)(P.KS + ((size_t)b * SKF + WIN + t) * KVW + 8 * lane) = w; op = P.out + O_KS + (size_t)(b * WIN + (WIN - DEC_T) + t) * KVW + 8 * lane; }
                    if (op != nullptr) { *(f32x4*)op = (f32x4){o[0], o[1], o[2], o[3]}; *(f32x4*)(op + 4) = (f32x4){o[4], o[5], o[6], o[7]}; }
                }
            }
        }
    }
    for (int item = (parts & 1) ? gw : M; item < M / 8; item += ngw) {
        const int r0 = item * 8; const int c4 = 4 * lane, kvh = c4 >> 6, d = c4 & 63;
        float v[8][4];
#pragma unroll
        for (int rr = 0; rr < 8; ++rr) { const u32x2 w = *(const u32x2*)(P.raw + (size_t)(r0 + rr) * NQKV + NH * HD + KVW + c4); v[rr][0] = bflo(w.x); v[rr][1] = bfhi(w.x); v[rr][2] = bflo(w.y); v[rr][3] = bfhi(w.y); }
        if (r0 < MP) {
            const int b = r0 >> 12, t0 = r0 & (SEQ - 1);
#pragma unroll
            for (int e = 0; e < 4; ++e) { u32x4 o; o.x = pk2(v[0][e], v[1][e]); o.y = pk2(v[2][e], v[3][e]); o.z = pk2(v[4][e], v[5][e]); o.w = pk2(v[6][e], v[7][e]);
                *(u32x4*)(P.VTP + ((size_t)(b * NKV + kvh) * HD + d + e) * SEQ + t0) = o; }
            if (t0 >= SEQ - WIN) {
#pragma unroll
                for (int rr = 0; rr < 8; ++rr) *(f32x4*)(P.out + O_VP + (size_t)(b * WIN + (t0 + rr - (SEQ - WIN))) * KVW + c4) = (f32x4){v[rr][0], v[rr][1], v[rr][2], v[rr][3]};
            }
        } else {
            const int b = (r0 - MP) >> 3;
#pragma unroll
            for (int e = 0; e < 4; ++e) { u32x4 o; o.x = pk2(v[0][e], v[1][e]); o.y = pk2(v[2][e], v[3][e]); o.z = pk2(v[4][e], v[5][e]); o.w = pk2(v[6][e], v[7][e]);
                bf16* vp = P.VTS + ((size_t)(b * NKV + kvh) * HD + d + e) * SVP; *(u32x4*)(vp + WIN) = o; *(u32x4*)(vp + WIN + 8) = (u32x4){0u, 0u, 0u, 0u}; }
#pragma unroll
            for (int rr = 0; rr < 8; ++rr) *(f32x4*)(P.out + O_VS + (size_t)(b * WIN + (WIN - DEC_T) + rr) * KVW + c4) = (f32x4){v[rr][0], v[rr][1], v[rr][2], v[rr][3]};
        }
    }
    for (int idx = (parts & 2) ? gtid : DEC_B * WIN * (KVW / 4); idx < DEC_B * WIN * (KVW / 4); idx += nthreads) {
        const int f = idx & (WIN - 1), c4 = ((idx >> 7) & 63) * 4, b = idx >> 13, kvh = c4 >> 6, d = c4 & 63;
        const f32x4 kc = *(const f32x4*)(P.cache_k + ((size_t)b * WIN + f) * KVW + c4), vc = *(const f32x4*)(P.cache_v + ((size_t)b * WIN + f) * KVW + c4);
        u32x2 kk; kk.x = pk2(kc[0], kc[1]); kk.y = pk2(kc[2], kc[3]);
        *(u32x2*)(P.KS + ((size_t)b * SKF + f) * KVW + c4) = kk;
#pragma unroll
        for (int e = 0; e < 4; ++e) P.VTS[((size_t)(b * NKV + kvh) * HD + d + e) * SVP + f] = (bf16)pk2(vc[e], 0.f);
        if (f >= DEC_T) { *(f32x4*)(P.out + O_KS + ((size_t)b * WIN + f - DEC_T) * KVW + c4) = kc; *(f32x4*)(P.out + O_VS + ((size_t)b * WIN + f - DEC_T) * KVW + c4) = vc; }
    }
}

constexpr int KROW = 144, VROW = 528, ATT_K_BYTES = 256 * KROW;
__device__ __forceinline__ void attn_phase(LAS unsigned char* lds, const bf16* __restrict__ Q, const bf16* __restrict__ KP, const bf16* __restrict__ VTP, const bf16* __restrict__ KS, const bf16* __restrict__ VTS,
                                           const float* __restrict__ sinks, bf16* __restrict__ O, int G) {
    int tid_ = threadIdx.x; asm volatile("" : "+v"(tid_)); const int tid = tid_, lane = tid & 63, wid = __builtin_amdgcn_readfirstlane(tid >> 6), fr = lane & 15, fq = lane >> 4;
    LAS unsigned char* Ksm = lds; LAS unsigned char* Vsm = lds + ATT_K_BYTES;
    for (int u = blockIdx.x; u < 256; u += G) {
        int nq, qrow0, f0, nk, nkv, kvh, vpitch; const bf16* kbase; const bf16* vbase;
        if (u < 256) { const int b = u >> 7, n = u & 31; kvh = (u >> 5) & 3; nq = 128; qrow0 = b * SEQ + n * 128; f0 = (n == 0) ? 128 : 0; nk = 256; nkv = 256;
            kbase = KP + ((long)(b * SEQ) + (long)(n - 1) * 128) * KVW + kvh * 64; vbase = VTP + (long)((b * NKV + kvh) * HD) * SEQ + (long)(n - 1) * 128; vpitch = SEQ; }
        else { const int s = u - 256, b = s >> 2; kvh = s & 3; nq = DEC_T; qrow0 = MP + b * DEC_T; f0 = 0; nk = SKF; nkv = SVP;
            kbase = KS + (long)b * SKF * KVW + kvh * 64; vbase = VTS + (long)((b * NKV + kvh) * HD) * SVP; vpitch = SVP; }
#pragma unroll
        for (int i = 0; i < 4; ++i) { const int id = tid + NTHREADS * i, f = id >> 3, c = id & 7; u32x4 v = (u32x4){0u, 0u, 0u, 0u};
            if (f >= f0 && f < nk) v = *(const u32x4*)(kbase + (long)f * KVW + c * 8);
            *(LAS u32x4*)(Ksm + f * KROW + c * 16) = v; }
#pragma unroll
        for (int i = 0; i < 4; ++i) { const int id = tid + NTHREADS * i, d = id >> 5, c = id & 31; u32x4 v = (u32x4){0u, 0u, 0u, 0u};
            if (8 * c >= f0 && 8 * c < nkv) v = *(const u32x4*)(vbase + (long)d * vpitch + 8 * c);
            *(LAS u32x4*)(Vsm + d * VROW + c * 16) = v; }
        __syncthreads();
        const int h = kvh * 8 + wid; const float sink2 = sinks[h] * LOG2E;
        const int nsub = (nq + 15) >> 4;
        for (int sp = 0; sp < 4; ++sp) {
            const int iA = 32 * sp + fr, iB = iA + 16, ktb = 2 * sp;
            const bf16* qpA = Q + (size_t)(qrow0 + iA) * D + h * 64 + 8 * fq; const bf16* qpB = qpA + 16 * D;
            const bf16x8 qA0 = *(const bf16x8*)qpA, qA1 = *(const bf16x8*)(qpA + 32), qB0 = *(const bf16x8*)qpB, qB1 = *(const bf16x8*)(qpB + 32);
            f32x4 sA[10], sB[10];
#pragma unroll
            for (int j = 0; j < 10; ++j) { const LAS unsigned char* kr = Ksm + (16 * (ktb + j) + fr) * KROW + fq * 16;
                const bf16x8 a0 = *(const LAS bf16x8*)kr, a1 = *(const LAS bf16x8*)(kr + 64);
                f32x4 accA = (f32x4){0.f, 0.f, 0.f, 0.f}, accB = accA;
                accA = __builtin_amdgcn_mfma_f32_16x16x32_bf16(a0, qA0, accA, 0, 0, 0); accB = __builtin_amdgcn_mfma_f32_16x16x32_bf16(a0, qB0, accB, 0, 0, 0);
                accA = __builtin_amdgcn_mfma_f32_16x16x32_bf16(a1, qA1, accA, 0, 0, 0); accB = __builtin_amdgcn_mfma_f32_16x16x32_bf16(a1, qB1, accB, 0, 0, 0); sA[j] = accA; sB[j] = accB; }
            float mxA = -INFINITY, mxB = -INFINITY;
#pragma unroll
            for (int j = 0; j < 10; ++j)
#pragma unroll
                for (int e = 0; e < 4; ++e) { const int f = 16 * (ktb + j) + 4 * fq + e;
                    const bool okA = (f >= iA + 1) && (f <= iA + WIN) && (f >= f0), okB = (f >= iB + 1) && (f <= iB + WIN) && (f >= f0);
                    sA[j][e] = okA ? sA[j][e] : -INFINITY; mxA = fmaxf(mxA, sA[j][e]); sB[j][e] = okB ? sB[j][e] : -INFINITY; mxB = fmaxf(mxB, sB[j][e]); }
            mxA = fmaxf(mxA, shx(mxA, 16, lane)); mxB = fmaxf(mxB, shx(mxB, 16, lane)); mxA = fmaxf(mxA, shx(mxA, 32, lane)); mxB = fmaxf(mxB, shx(mxB, 32, lane));
            mxA = fmaxf(mxA, sink2); mxB = fmaxf(mxB, sink2);
            float lA = 0.f, lB = 0.f;
#pragma unroll
            for (int j = 0; j < 10; ++j)
#pragma unroll
                for (int e = 0; e < 4; ++e) { const float pA = __builtin_amdgcn_exp2f(sA[j][e] - mxA), pB = __builtin_amdgcn_exp2f(sB[j][e] - mxB); sA[j][e] = pA; lA += pA; sB[j][e] = pB; lB += pB; }
            lA += shx(lA, 16, lane); lB += shx(lB, 16, lane); lA += shx(lA, 32, lane); lB += shx(lB, 32, lane);
            lA += __builtin_amdgcn_exp2f(sink2 - mxA); lB += __builtin_amdgcn_exp2f(sink2 - mxB);
            f32x4 oA[4], oB[4];
#pragma unroll
            for (int dt = 0; dt < 4; ++dt) { oA[dt] = (f32x4){0.f, 0.f, 0.f, 0.f}; oB[dt] = oA[dt]; }
#pragma unroll
            for (int jp = 0; jp < 5; ++jp) {
                u32x4 pw; pw.x = pk2(sA[2 * jp][0], sA[2 * jp][1]); pw.y = pk2(sA[2 * jp][2], sA[2 * jp][3]); pw.z = pk2(sA[2 * jp + 1][0], sA[2 * jp + 1][1]); pw.w = pk2(sA[2 * jp + 1][2], sA[2 * jp + 1][3]);
                const bf16x8 pbA = __builtin_bit_cast(bf16x8, pw);
                pw.x = pk2(sB[2 * jp][0], sB[2 * jp][1]); pw.y = pk2(sB[2 * jp][2], sB[2 * jp][3]); pw.z = pk2(sB[2 * jp + 1][0], sB[2 * jp + 1][1]); pw.w = pk2(sB[2 * jp + 1][2], sB[2 * jp + 1][3]);
                const bf16x8 pbB = __builtin_bit_cast(bf16x8, pw);
#pragma unroll
                for (int dt = 0; dt < 4; ++dt) { const LAS unsigned char* vr = Vsm + (16 * dt + fr) * VROW + (16 * (ktb + 2 * jp) + 4 * fq) * 2;
                    const u32x2 lo = *(const LAS u32x2*)vr, hi = *(const LAS u32x2*)(vr + 32);
                    const bf16x8 a = __builtin_bit_cast(bf16x8, (u32x4){lo.x, lo.y, hi.x, hi.y});
                    oA[dt] = __builtin_amdgcn_mfma_f32_16x16x32_bf16(a, pbA, oA[dt], 0, 0, 0); oB[dt] = __builtin_amdgcn_mfma_f32_16x16x32_bf16(a, pbB, oB[dt], 0, 0, 0); }
            }
            const float rlA = 1.0f / lA, rlB = 1.0f / lB;
            bf16* opA = O + (size_t)(qrow0 + iA) * D + h * 64 + 4 * fq; bf16* opB = opA + 16 * D;
#pragma unroll
            for (int dt = 0; dt < 4; ++dt) { u32x2 w; w.x = pk2(oA[dt][0] * rlA, oA[dt][1] * rlA); w.y = pk2(oA[dt][2] * rlA, oA[dt][3] * rlA); *(u32x2*)(opA + 16 * dt) = w;
                w.x = pk2(oB[dt][0] * rlB, oB[dt][1] * rlB); w.y = pk2(oB[dt][2] * rlB, oB[dt][3] * rlB); *(u32x2*)(opB + 16 * dt) = w; }
        }
        __syncthreads();
    }
}

__device__ __forceinline__ void sample_attn(const bf16* __restrict__ Q, const bf16* __restrict__ KS, const bf16* __restrict__ VTS, const float* __restrict__ sinks, bf16* __restrict__ O, int gw, int ngw, int lane) {
    for (int item = gw; item < MS * NH; item += ngw) {
        const int r = item >> 5, h = item & 31, b = r >> 3, t = r & 7, kvh = h >> 3;
        const bf16* qp = Q + (size_t)(MP + r) * D + h * 64;
        float q[64];
#pragma unroll
        for (int c = 0; c < 8; ++c) { const u32x4 w = *(const u32x4*)(qp + 8 * c); q[8 * c] = bflo(w.x); q[8 * c + 1] = bfhi(w.x); q[8 * c + 2] = bflo(w.y); q[8 * c + 3] = bfhi(w.y); q[8 * c + 4] = bflo(w.z); q[8 * c + 5] = bfhi(w.z); q[8 * c + 6] = bflo(w.w); q[8 * c + 7] = bfhi(w.w); }
        const bf16* vp = VTS + ((size_t)(b * NKV + kvh) * HD + lane) * SVP;
        u32x4 vv[17];
#pragma unroll
        for (int c = 0; c < 17; ++c) vv[c] = *(const u32x4*)(vp + 8 * c);
        float sc[3]; float mx = sinks[h] * LOG2E; const float sink2 = mx;
#pragma unroll
        for (int k = 0; k < 3; ++k) {
            const int f = lane + 64 * k; float s = -INFINITY;
            if (f >= t + 1 && f <= t + WIN && f < SKF) {
                const bf16* kp = KS + ((size_t)b * SKF + f) * KVW + kvh * 64; s = 0.f;
#pragma unroll
                for (int c = 0; c < 8; ++c) { const u32x4 w = *(const u32x4*)(kp + 8 * c);
                    s += q[8 * c] * bflo(w.x) + q[8 * c + 1] * bfhi(w.x) + q[8 * c + 2] * bflo(w.y) + q[8 * c + 3] * bfhi(w.y) + q[8 * c + 4] * bflo(w.z) + q[8 * c + 5] * bfhi(w.z) + q[8 * c + 6] * bflo(w.w) + q[8 * c + 7] * bfhi(w.w); }
            }
            sc[k] = s; mx = fmaxf(mx, s);
        }
#pragma unroll
        for (int o = 1; o < 64; o <<= 1) mx = fmaxf(mx, shx(mx, o, lane));
        float l = 0.f;
#pragma unroll
        for (int k = 0; k < 3; ++k) { sc[k] = __builtin_amdgcn_exp2f(sc[k] - mx); l += sc[k]; }
        l = wave_sum(l, lane) + __builtin_amdgcn_exp2f(sink2 - mx);
        float o = 0.f;
#pragma unroll
        for (int c = 0; c < 17; ++c) {
            const int k = (8 * c) >> 6;
#pragma unroll
            for (int e = 0; e < 8; ++e) { const int f = 8 * c + e; const float pf = __int_as_float(__builtin_amdgcn_ds_bpermute((f & 63) << 2, __float_as_int(sc[k])));
                const unsigned w = (e < 2) ? vv[c].x : (e < 4) ? vv[c].y : (e < 6) ? vv[c].z : vv[c].w; o += pf * ((e & 1) ? bfhi(w) : bflo(w)); }
        }
        O[(size_t)(MP + r) * D + h * 64 + lane] = (bf16)pk2(o / l, 0.f);
    }
}

#define XB_TMO      128
#define XB_XCNT(j)  (256  + 64 * (j))
#define XB_XSUB(j)  (1280 + 64 * (j))
#define XB_XGEN(j)  (2304 + 64 * (j))
#define XB_TOP      3328
#define XB_TOPGEN   3392
#define XCD_BAR_WORDS 3456
#define XB_SPIN_CAP (1u << 18)

__device__ __forceinline__ unsigned xb_ld(unsigned* p)              { return __hip_atomic_load(p, __ATOMIC_RELAXED, __HIP_MEMORY_SCOPE_AGENT); }
__device__ __forceinline__ unsigned xb_add(unsigned* p, unsigned v) { return __hip_atomic_fetch_add(p, v, __ATOMIC_RELAXED, __HIP_MEMORY_SCOPE_AGENT); }
__device__ __forceinline__ unsigned xb_xcc_id() { return (unsigned)__builtin_amdgcn_s_getreg((3 << 11) | 20) & 0xFu; }
#define XB_SPIN(cond, bar) do { unsigned _sp = 0; while (cond) { __builtin_amdgcn_s_sleep(1); \
    if ((++_sp & 255u) == 0u) { if (xb_ld(&(bar)[XB_TMO])) break; if (_sp > XB_SPIN_CAP) { atomicAdd(&(bar)[XB_TMO], 1u); break; } } } } while (0)

struct XcdBarrier {
    unsigned* bar; unsigned x;
    volatile LAS unsigned* st;
};

__device__ __forceinline__ XcdBarrier xcd_barrier_post(unsigned* bar, volatile LAS unsigned* st) {
    XcdBarrier b; b.bar = bar; b.x = xb_xcc_id(); b.st = st;
    if (threadIdx.x == 0) (void)xb_add(&bar[XB_XCNT(b.x)], 1u);
    return b;
}
__device__ __forceinline__ void xcd_barrier_complete(unsigned* bar, unsigned x, unsigned& nloc, unsigned& nx) {
    const unsigned G = gridDim.x * gridDim.y * gridDim.z;
    unsigned sum, cnt, mine, sp = 0u;
    for (;;) {
        sum = 0u; cnt = 0u; mine = 0u;
#pragma unroll
        for (unsigned j = 0; j < 16; ++j) { const unsigned c = xb_ld(&bar[XB_XCNT(j)]); sum += c; cnt += (c > 0u) ? 1u : 0u; mine = (j == x) ? c : mine; }
        if (sum == G) break;
        __builtin_amdgcn_s_sleep(1);
        if ((++sp & 255u) == 0u) { if (xb_ld(&bar[XB_TMO])) break; if (sp > XB_SPIN_CAP) { atomicAdd(&bar[XB_TMO], 1u); break; } }
    }
    nloc = mine > 0u ? mine : 1u; nx = cnt > 0u ? cnt : 1u;
}

__device__ __forceinline__ void xcd_barrier(const XcdBarrier& b) {
    asm volatile("s_waitcnt vmcnt(0)" ::: "memory");
    __syncthreads();
    if (threadIdx.x == 0) {
        unsigned* bar = b.bar;
        __builtin_amdgcn_s_waitcnt(0);
        unsigned nloc = b.st[0], nx = b.st[1];
        if (nloc == 0u) { xcd_barrier_complete(bar, b.x, nloc, nx); b.st[0] = nloc; b.st[1] = nx; }
        const unsigned old = xb_add(&bar[XB_XSUB(b.x)], 1u);
        const unsigned gen = old / nloc;
        if (old + 1u == (gen + 1u) * nloc) {
            __builtin_amdgcn_fence(__ATOMIC_RELEASE, "agent");
            asm volatile("s_waitcnt vmcnt(0)" ::: "memory");
            const unsigned og = xb_add(&bar[XB_TOP], 1u);
            const unsigned tg = og / nx;
            if (og + 1u == (tg + 1u) * nx) xb_add(&bar[XB_TOPGEN], 1u);
            else XB_SPIN(xb_ld(&bar[XB_TOPGEN]) == tg, bar);
            __builtin_amdgcn_fence(__ATOMIC_ACQUIRE, "agent");
            xb_add(&bar[XB_XGEN(b.x)], 1u);
            asm volatile("s_waitcnt vmcnt(0)" ::: "memory");
        } else {
            XB_SPIN(xb_ld(&bar[XB_XGEN(b.x)]) == gen, bar);
            __builtin_amdgcn_fence(__ATOMIC_ACQUIRE, "agent");
            asm volatile("s_waitcnt vmcnt(0)" ::: "memory");
        }
    }
    __syncthreads();
}

struct Args { const float* in[17]; float* out; unsigned char* ws; int ph_lo, ph_hi; };
template <int BYTE_OFF> __device__ __forceinline__ const float* karg_ptr() {
    __attribute__((address_space(1))) const float* p; const char* ka = (const char*)__builtin_amdgcn_kernarg_segment_ptr();
    asm volatile("s_load_dwordx2 %0, %1, %2\n\ts_waitcnt lgkmcnt(0)" : "=s"(p) : "s"(ka), "n"(BYTE_OFF) : "memory");
    return (const float*)p;
}
#define ARG_IN(i) karg_ptr<8 * (i)>()

struct GemmDesc { const bf16* A; const bf16* Bt; int N, K, type, ldc; bf16* outb; const float* srcP; };

__global__ void __launch_bounds__(NTHREADS, 2) fwd_megakernel(Args a) {
    extern __shared__ __attribute__((aligned(16))) unsigned char lds_raw[];
    cg::grid_group grid = cg::this_grid();
    LAS unsigned char* lds = (LAS unsigned char*)lds_raw;
    const int G = gridDim.x, ngw = G * NWAVES, nthreads = G * NTHREADS;
    if (threadIdx.x < 16) ((LAS unsigned*)(lds + LDS_RING))[threadIdx.x] = 0u;
    __syncthreads();
    (void)xcd_barrier_post((unsigned*)((unsigned char*)karg_ptr<144>() + WS_BAR), (volatile LAS unsigned*)(lds + LDS_RING));
#ifndef DBG_PH
#define DBG_PH 15
#endif
#pragma unroll 1
    for (int ph = a.ph_lo; ph <= a.ph_hi; ++ph) {
        int tid_ = threadIdx.x; asm volatile("" : "+v"(tid_));
        const int tid = tid_, lane = tid & 63, wave = __builtin_amdgcn_readfirstlane(tid >> 6);
        const int gw = blockIdx.x * NWAVES + wave, gtid = blockIdx.x * NTHREADS + tid;
        unsigned char* ws = (unsigned char*)karg_ptr<144>(); float* out = (float*)karg_ptr<136>();
    bf16* const WT[8] = {(bf16*)(ws + WS_WIN), (bf16*)(ws + WS_WOUT), (bf16*)(ws + WS_WQKV), (bf16*)(ws + WS_WATT), (bf16*)(ws + WS_WUP0), (bf16*)(ws + WS_WUP1), (bf16*)(ws + WS_WDN0), (bf16*)(ws + WS_WDN1)};
    bf16* const H0 = (bf16*)(ws + WS_H); bf16* const H1 = (bf16*)(ws + WS_HX); bf16* const H2 = (bf16*)(ws + WS_HX + 33 * MiB); bf16* const H3 = (bf16*)(ws + WS_HX + 66 * MiB); bf16* const BCV = (bf16*)(ws + WS_BCV); bf16* const GB = (bf16*)(ws + WS_G); bf16* const AB = (bf16*)(ws + WS_A);
    bf16* const QKV = (bf16*)(ws + WS_QKV); bf16* const QB = (bf16*)(ws + WS_Q); bf16* const OB = (bf16*)(ws + WS_O);
    float* const RS1 = (float*)(ws + WS_RSS); float* const RS2 = RS1 + M; float* const RS3 = RS2 + M;
    bf16* const YB = H1;
    bf16* const KP = (bf16*)(ws + WS_KP); bf16* const VTP = (bf16*)(ws + WS_VTP); bf16* const KS = (bf16*)(ws + WS_KS); bf16* const VTS = (bf16*)(ws + WS_VTS);

        const bool tails = G >= 128;
#define CONVERT_ITEMS(LO, HI, FIRST, STRIDE) { LAS unsigned* T = (LAS unsigned*)(lds + wave * (64 * 33 * 4)); \
            for (int it = (LO) + (FIRST); it < (HI); it += (STRIDE)) { \
                int r = it; const float* W; const float* gain = nullptr; bf16* dst; int K = D, N; \
                if (r < 3072) { W = ARG_IN(7); gain = ARG_IN(5); dst = WT[0]; N = NIN; } \
                else if ((r -= 3072) < 1024) { W = ARG_IN(9); dst = WT[1]; N = D; } \
                else if ((r -= 1024) < 1280) { W = ARG_IN(10); gain = ARG_IN(5) + D; dst = WT[2]; N = NQKV; } \
                else if ((r -= 1280) < 1024) { W = ARG_IN(11); dst = WT[3]; N = D; } \
                else if ((r -= 1024) < 4096) { W = ARG_IN(15); gain = ARG_IN(6); dst = WT[4]; N = FF; } \
                else if ((r -= 4096) < 4096) { W = ARG_IN(15) + (size_t)D * FF; gain = ARG_IN(6) + D; dst = WT[5]; N = FF; } \
                else if ((r -= 4096) < 4096) { W = ARG_IN(16); dst = WT[6]; K = FF; N = D; } \
                else { r -= 4096; W = ARG_IN(16) + (size_t)D * FF; dst = WT[7]; K = FF; N = D; } \
                transpose_item(W, gain, dst, K, N, r, T, lane); } }
#ifdef DBG_EMPTY_FROM
        if (ph >= DBG_EMPTY_FROM) {   } else
#endif
        if (ph == 0) {
            if (tails) { CONVERT_ITEMS(0, 3072, gw, ngw) } else { CONVERT_ITEMS(0, 22784, gw, ngw) }
            __syncthreads();
            for (int i = gtid; i < 3 * M; i += nthreads) RS1[i] = 0.f;
            rms_rows(ARG_IN(0), ARG_IN(1), H0, out + (size_t)MP * D, nullptr, 0, (LAS float*)(lds + 8 * 8448), true, nullptr, gw, ngw, lane);
        } else if (ph == 2) {
            conv_phase(BCV, ARG_IN(2), ARG_IN(8), GB, out + O_CP, out + O_CS, gtid, nthreads);
        } else if (ph == 4 || ph == 7 || ph == 12) {
            rms_rows(nullptr, out + (size_t)MP * D, YB, out + (size_t)MP * D, (const float*)(ws + WS_PART), ph == 7 ? 16 : 8, (LAS float*)(lds + 8 * 8448), false, ph == 4 ? RS1 : (ph == 7 ? RS2 : RS3), gw, ngw, lane);
        } else if (ph == 15) {
            reduce_sample(out + (size_t)MP * D, (const float*)(ws + WS_PART), 16, gw, ngw, lane);
        } else if (ph == 9) {
            PostArgs P{QKV, ARG_IN(12), ARG_IN(13), ARG_IN(3), ARG_IN(4), QB, KP, VTP, KS, VTS, out};
            post_phase(P, gw, ngw, lane, gtid, nthreads, tails ? 1 : 3);
        } else if (ph == 10) {
            attn_phase(lds, QB, KP, VTP, KS, VTS, ARG_IN(14), OB, G);
            sample_attn(QB, KS, VTS, ARG_IN(14), OB, gw, ngw, lane);
        } else {
#define RUN_BF16(ACT, ID, Aptr, Bptr, NN, KK, OUT, RSS) { const pg8::Gemm gg{Aptr, Bptr, M, NN, KK}; pg8::StaticOrderT<M, NN, KK> S; S.G = G; S.c = (int)blockIdx.x; const pg8::EpiBf16<ACT, ID> E{OUT, NN, RSS}; \
                pg8::gemm_phase<pg8::EpiBf16<ACT, ID>, pg8::StaticOrderT<M, NN, KK>, true, true>(lds, gg, S, E); }
#define RUN_RES(ID, MODE, Aptr, Bptr, KK, NS, SRCF, RSS) { const pg8::Gemm gg{Aptr, Bptr, M, D, KK}; pg8::SplitOrderT<KK, NS> S; S.G = G; S.c = (int)blockIdx.x; \
                const pg8::EpiRes2<ID, MODE> E{SRCF, YB, out, (float*)(ws + WS_PART), RSS}; pg8::gemm_phase<pg8::EpiRes2<ID, MODE>, pg8::SplitOrderT<KK, NS>, true, true>(lds, gg, S, E); }
            if (ph == 1) RUN_BF16(0, 1, H0, WT[0], NIN, D, BCV, nullptr)
            else if (ph == 3) RUN_RES(3, 0, GB, WT[1], D, 8, ARG_IN(0), RS1)
            else if (ph == 5) RUN_BF16(1, 5, YB, WT[4], FF, D, AB, RS1)
            else if (ph == 6) RUN_RES(6, 1, AB, WT[6], FF, 16, nullptr, RS2)
            else if (ph == 8) RUN_BF16(0, 8, YB, WT[2], NQKV, D, QKV, RS2)
            else if (ph == 11) RUN_RES(11, 1, OB, WT[3], D, 8, nullptr, RS3)
            else if (ph == 13) RUN_BF16(1, 13, YB, WT[5], FF, D, AB, RS3)
            else RUN_RES(14, 2, AB, WT[7], FF, 16, nullptr, (float*)nullptr)
#undef RUN_BF16
#undef RUN_RES
            if (tails && ph == 1 && blockIdx.x >= 24) { const int hw = ((int)blockIdx.x - 24) * NWAVES + wave, nhw = (G - 24) * NWAVES;
                CONVERT_ITEMS(3072, 4096, hw, nhw) CONVERT_ITEMS(6400, 10496, hw, nhw) CONVERT_ITEMS(14592, 18688, hw, nhw) }
            if (tails && ph == 8 && blockIdx.x >= 74) {
                PostArgs P{QKV, ARG_IN(12), ARG_IN(13), ARG_IN(3), ARG_IN(4), QB, KP, VTP, KS, VTS, out};
                post_phase(P, 0, 1, lane, ((int)blockIdx.x - 74) * NTHREADS + tid, (G - 74) * NTHREADS, 2); }
            if (tails && ph == 5 && blockIdx.x >= 32) { const int hw = ((int)blockIdx.x - 32) * NWAVES + wave, nhw = (G - 32) * NWAVES;
                CONVERT_ITEMS(4096, 6400, hw, nhw) CONVERT_ITEMS(10496, 14592, hw, nhw) CONVERT_ITEMS(18688, 22784, hw, nhw) }
        }
        if (a.ph_lo == 0 && (ph != a.ph_hi || DBG_PH != 15)) {
            XcdBarrier xb; xb.bar = (unsigned*)(ws + WS_BAR); xb.x = xb_xcc_id(); xb.st = (volatile LAS unsigned*)(lds + LDS_RING);
            xcd_barrier(xb);
        } else
        if (ph != a.ph_hi || DBG_PH != 15) {
            asm volatile("s_waitcnt vmcnt(0)" ::: "memory");
            __syncthreads();
            if (threadIdx.x == 0) { __builtin_amdgcn_fence(__ATOMIC_RELEASE, "agent"); asm volatile("s_waitcnt vmcnt(0)" ::: "memory"); }
            grid.sync();
            if (threadIdx.x == 0) { __builtin_amdgcn_fence(__ATOMIC_ACQUIRE, "agent"); asm volatile("s_waitcnt vmcnt(0)" ::: "memory"); }
            __syncthreads();
        }
    }
#if DBG_PH != 15
    {
        const int gtid = blockIdx.x * NTHREADS + threadIdx.x; unsigned char* ws = (unsigned char*)karg_ptr<144>(); float* out = (float*)karg_ptr<136>();
        const unsigned* w0 = (const unsigned*)(ws); const unsigned* w1 = (const unsigned*)(ws + WS_H); const unsigned* w2 = (const unsigned*)(ws + WS_R);
        unsigned x0 = 0, x1 = 0, x2 = 0;
        for (size_t i = gtid; i < (178 * MiB) / 4; i += nthreads) x0 ^= w0[i];
        for (size_t i = gtid; i < (33 * MiB) / 4; i += nthreads) x1 ^= w1[i];
        for (size_t i = gtid; i < (174 * MiB) / 4; i += nthreads) x2 ^= w2[i];
        out[O_KS + gtid] = (float)((x0 ^ (x0 >> 12)) & 0xfffffu); out[O_KS + nthreads + gtid] = (float)((x1 ^ (x1 >> 12)) & 0xfffffu); out[O_KS + 2 * nthreads + gtid] = (float)((x2 ^ (x2 >> 12)) & 0xfffffu);
    }
#endif
}

extern "C" void kernel_launch(void* const* d_in, const int* in_sizes, int n_in, void* d_out, int out_size, void* d_ws, size_t ws_size, hipStream_t stream) {
    static int grid_blocks = 0;
    if (grid_blocks == 0) {
        if (n_in != 17 || ws_size < WS_END) { fprintf(stderr, "kernel_launch: unexpected inputs (n_in %d, ws %zu)\n", n_in, ws_size); grid_blocks = -1; return; }
        int dev = 0, cus = 0, per_cu = 0;
        if (hipGetDevice(&dev) != hipSuccess || hipDeviceGetAttribute(&cus, hipDeviceAttributeMultiprocessorCount, dev) != hipSuccess) { grid_blocks = -1; return; }
        if (hipFuncSetAttribute((const void*)fwd_megakernel, hipFuncAttributeMaxDynamicSharedMemorySize, LDS_BYTES) != hipSuccess) { fprintf(stderr, "kernel_launch: hipFuncSetAttribute failed\n"); grid_blocks = -1; return; }
        if (hipOccupancyMaxActiveBlocksPerMultiprocessor(&per_cu, (const void*)fwd_megakernel, NTHREADS, LDS_BYTES) != hipSuccess || per_cu < 1) { fprintf(stderr, "kernel_launch: occupancy query reports %d blocks per CU\n", per_cu); grid_blocks = -1; return; }
        grid_blocks = cus;
    }
    if (grid_blocks < 0) return;
    Args a{};
    for (int i = 0; i < 17; ++i) a.in[i] = (const float*)d_in[i];
    a.out = (float*)d_out; a.ws = (unsigned char*)d_ws;
#ifndef MK_LAUNCHES
#define MK_LAUNCHES 1
#endif
    if (hipMemsetAsync((char*)d_ws + WS_BAR, 0, 16384, stream) != hipSuccess) { fprintf(stderr, "kernel_launch: hipMemsetAsync of the barrier words failed\n"); return; }
    void* args[] = {&a};
    if (MK_LAUNCHES == 1) {
        a.ph_lo = 0; a.ph_hi = DBG_PH;
        hipError_t e = hipLaunchCooperativeKernel((const void*)fwd_megakernel, dim3(grid_blocks), dim3(NTHREADS), args, LDS_BYTES, stream);
        if (e != hipSuccess) fprintf(stderr, "cooperative launch failed: %s (grid %d)\n", hipGetErrorString(e), grid_blocks);
    } else {
        for (int ph = 0; ph <= DBG_PH; ++ph) {
            a.ph_lo = ph; a.ph_hi = ph;
            hipError_t e = hipLaunchCooperativeKernel((const void*)fwd_megakernel, dim3(grid_blocks), dim3(NTHREADS), args, LDS_BYTES, stream);
            if (e != hipSuccess) { fprintf(stderr, "launch %d failed: %s\n", ph, hipGetErrorString(e)); break; }
        }
    }
}
```
